# Optimizing an MI355X kernel written in HIP

```python
import math
import jax
import jax.numpy as jnp
from jax import lax
import numpy as np

D_MODEL = 1024
BATCH = 4
SEQ = 8192
DEPTH = 2

CTX_LEN = 256
GRID_W = 64
N_ATT_LAYERS = (DEPTH + 1) // 2
N_REC_LAYERS = DEPTH // 2

NA_HEADS = 8
NA_HEAD_DIM = 64
NA_WIN_ROWS = 8
NA_WIN_COLS = 16
DIFF_HEADS = 4
DIFF_HEAD_DIM = 64
DIFF_BLOCK = 128
HGRN_HEADS = 4
HGRN_HEAD_DIM = 128
GDN_HEADS = 4
GDN_HEAD_DIM = 128
SHORT_CONV = 3
CHUNK = 64
D_FF = -(-8 * D_MODEL // (3 * 256)) * 256

NA_W = NA_HEADS * NA_HEAD_DIM
DF_W = DIFF_HEADS * 2 * DIFF_HEAD_DIM
ATT_IN = 3 * NA_W + 3 * DF_W
HG_W = HGRN_HEADS * HGRN_HEAD_DIM
GD_W = GDN_HEADS * GDN_HEAD_DIM
REC_IN = 5 * HG_W + 4 * GD_W + 4 * GDN_HEADS
MIX_W = NA_W + DF_W

ROPE_THETA = 10000.0
EPS = 1e-6
NEG_INF = -1e30

kernel_name = 'hybrid_diffusion_trunk'


def rmsnorm(x, w):
    xf = x.astype(jnp.float32)
    y = xf * lax.rsqrt(jnp.mean(xf * xf, axis=-1, keepdims=True) + EPS)
    return (y * w.astype(jnp.float32)).astype(x.dtype)


def l2norm(t):
    return t * lax.rsqrt(jnp.sum(t * t, axis=-1, keepdims=True) + EPS)


def to_heads(t, n_heads):
    b, s, _ = t.shape
    return t.reshape(b, s, n_heads, -1).transpose(0, 2, 1, 3)


def from_heads(t):
    b, h, s, d = t.shape
    return t.transpose(0, 2, 1, 3).reshape(b, s, h * d)


def adaln(cvec, w, b):
    return jnp.split(jax.nn.silu(cvec) @ w + b, 6, axis=-1)


def modulate(h, shift, scale):
    return h * (1 + scale) + shift


def swiglu(h, w_gate, w_up, w_down):
    return (jax.nn.silu(h @ w_gate) * (h @ w_up)) @ w_down


def axial_rope(x, rows, cols):
    half = x.shape[-1] // 2
    quarter = half // 2
    inv_freq = ROPE_THETA ** (-jnp.arange(quarter, dtype=jnp.float32) / quarter)

    def rotate(xp, pos):
        ang = pos.astype(jnp.float32)[:, None] * inv_freq
        cos, sin = jnp.cos(ang), jnp.sin(ang)
        x1 = xp[..., :quarter].astype(jnp.float32)
        x2 = xp[..., quarter:].astype(jnp.float32)
        return jnp.concatenate([x1 * cos - x2 * sin, x2 * cos + x1 * sin], axis=-1)

    return jnp.concatenate([rotate(x[..., :half], rows), rotate(x[..., half:], cols)], axis=-1).astype(x.dtype)


def softmax_attend(q, k, v):
    s = jnp.einsum('bhqd,bhkd->bhqk', q, k).astype(jnp.float32) * (q.shape[-1] ** -0.5)
    p = jax.nn.softmax(s, axis=-1)
    return jnp.einsum('bhqk,bhkd->bhqd', p.astype(v.dtype), v)


def diff_attend(q, k, v, lam):
    s = jnp.einsum('bhmqd,bhmkd->bhmqk', q, k).astype(jnp.float32) * (q.shape[-1] ** -0.5)
    p = jax.nn.softmax(s, axis=-1)
    p = p[:, :, 0] - lam * p[:, :, 1]
    return jnp.einsum('bhqk,bhkd->bhqd', p.astype(v.dtype), v)


def neighbourhood_attention(q, k, v, kc, vc, rpb):
    b, h, t, hd = q.shape
    rows = t // GRID_W
    kh = min(NA_WIN_ROWS, rows)
    kw = NA_WIN_COLS
    scale = hd ** -0.5
    qg = q.reshape(b, h, rows, GRID_W, hd)
    kg = k.reshape(b, h, rows, GRID_W, hd)
    vg = v.reshape(b, h, rows, GRID_W, hd)
    col = jnp.arange(GRID_W)
    col_start = jnp.clip(col - kw // 2, 0, GRID_W - kw)
    col_ok = (col[None, :] >= col_start[:, None]) & (col[None, :] < col_start[:, None] + kw)
    col_idx = jnp.clip(col[None, :] - col[:, None] + kw - 1, 0, 2 * kw - 2)
    rpb_cols = rpb[:, :, col_idx]

    def one_row(r):
        r0 = jnp.clip(r - kh // 2, 0, rows - kh)
        qr = lax.dynamic_index_in_dim(qg, r, axis=2, keepdims=False)
        kr = lax.dynamic_slice_in_dim(kg, r0, kh, axis=2)
        vr = lax.dynamic_slice_in_dim(vg, r0, kh, axis=2)
        dr = r0 + jnp.arange(kh) - r + NA_WIN_ROWS - 1
        bias = jnp.take(rpb_cols, dr, axis=1).transpose(0, 2, 1, 3).astype(jnp.float32)
        s_win = jnp.einsum('bhqd,bhawd->bhqaw', qr, kr).astype(jnp.float32) * scale + bias[None]
        s_win = jnp.where(col_ok[:, None, :], s_win, NEG_INF).reshape(b, h, GRID_W, kh * GRID_W)
        s_ctx = jnp.einsum('bhqd,bhcd->bhqc', qr, kc).astype(jnp.float32) * scale
        p = jax.nn.softmax(jnp.concatenate([s_win, s_ctx], axis=-1), axis=-1).astype(v.dtype)
        p_win = p[..., :kh * GRID_W].reshape(b, h, GRID_W, kh, GRID_W)
        p_ctx = p[..., kh * GRID_W:]
        return jnp.einsum('bhqaw,bhawd->bhqd', p_win, vr) + jnp.einsum('bhqc,bhcd->bhqd', p_ctx, vc)

    out = lax.map(one_row, jnp.arange(rows))
    return out.transpose(1, 2, 0, 3, 4).reshape(b, h, t, hd)


def centred_dwconv(x, w):
    k, c = w.shape
    return lax.conv_general_dilated(x, w[:, None, :].astype(x.dtype), window_strides=(1,),
                                    padding=[(k // 2, k // 2)], dimension_numbers=('NWC', 'WIO', 'NWC'),
                                    feature_group_count=c)


def _chunks_first(t):
    return jnp.moveaxis(t, 2, 0)


def gla_chunk(q, k, v, g, s0, with_output):
    b, h, t, dk = k.shape
    dv = v.shape[-1]
    n = t // CHUNK
    q, k, v, g = [a.reshape(b, h, n, CHUNK, a.shape[-1]) for a in (q, k, v, g)]
    G = jnp.cumsum(g, axis=3)
    G_last = G[:, :, :, -1:, :]
    k_tail = k * jnp.exp(G_last - G)
    decay = jnp.exp(G_last[:, :, :, 0, :])
    xs = (_chunks_first(k_tail), _chunks_first(v), _chunks_first(decay))
    if with_output:
        causal = jnp.tril(jnp.ones((CHUNK, CHUNK), dtype=bool))
        a = jnp.einsum('bhncd,bhnsd->bhncs', q * jnp.exp(G - G_last), k_tail)
        o_intra = jnp.einsum('bhncs,bhnse->bhnce', jnp.where(causal, a, 0.0), v)
        xs = xs + (_chunks_first(q * jnp.exp(G)),)

    def step(S, xs_n):
        k_n, v_n, d_n = xs_n[:3]
        o = jnp.einsum('bhcd,bhde->bhce', xs_n[3], S) if with_output else None
        return S * d_n[..., None] + jnp.einsum('bhcd,bhce->bhde', k_n, v_n), o

    S, o_inter = lax.scan(step, s0, xs)
    if not with_output:
        return None, S
    return (jnp.moveaxis(o_inter, 0, 2) + o_intra).reshape(b, h, t, dv), S


def gdn_chunk(q, k, v, g, beta, s0, with_output):
    b, h, t, dk = k.shape
    dv = v.shape[-1]
    n = t // CHUNK
    q, k, v = [a.reshape(b, h, n, CHUNK, a.shape[-1]) for a in (q, k, v)]
    g, beta = [a.reshape(b, h, n, CHUNK) for a in (g, beta)]
    G = jnp.cumsum(g, axis=-1)
    idx = jnp.arange(CHUNK)
    lower = idx[:, None] >= idx[None, :]
    strict = idx[:, None] > idx[None, :]
    gamma = jnp.exp(jnp.where(lower, G[..., :, None] - G[..., None, :], -jnp.inf))
    kb = k * beta[..., None]
    a = jnp.where(strict, jnp.einsum('bhncd,bhnsd->bhncs', kb, k) * gamma, 0.0)
    w = lax.linalg.triangular_solve(a, kb * jnp.exp(G)[..., None], left_side=True, lower=True, unit_diagonal=True)
    u = lax.linalg.triangular_solve(a, v * beta[..., None], left_side=True, lower=True, unit_diagonal=True)
    k_tail = k * jnp.exp(G[..., -1:] - G)[..., None]
    decay = jnp.exp(G[..., -1])
    xs = (_chunks_first(w), _chunks_first(u), _chunks_first(k_tail), _chunks_first(decay))
    if with_output:
        a_qk = jnp.einsum('bhncd,bhnsd->bhncs', q, k) * gamma
        xs = xs + (_chunks_first(q * jnp.exp(G)[..., None]), _chunks_first(a_qk))

    def step(S, xs_n):
        w_n, u_n, kt_n, d_n = xs_n[:4]
        v_new = u_n - jnp.einsum('bhcd,bhde->bhce', w_n, S)
        o = None
        if with_output:
            o = jnp.einsum('bhcd,bhde->bhce', xs_n[4], S) + jnp.einsum('bhcs,bhse->bhce', xs_n[5], v_new)
        return S * d_n[..., None, None] + jnp.einsum('bhcd,bhce->bhde', kt_n, v_new), o

    S, o = lax.scan(step, s0, xs)
    if not with_output:
        return None, S
    return jnp.moveaxis(o, 0, 2).reshape(b, h, t, dv), S


def directional_scan(chunk_fn, ctx_in, lat_in, reverse, need_ctx):
    flip = (lambda a: jnp.flip(a, axis=2)) if reverse else (lambda a: a)
    ctx_in = tuple(flip(a) for a in ctx_in)
    lat_in = tuple(flip(a) for a in lat_in)
    b, h, _, dk = ctx_in[1].shape
    s0 = jnp.zeros((b, h, dk, ctx_in[2].shape[-1]), jnp.float32)
    o_ctx, s_ctx = chunk_fn(*ctx_in, s0, need_ctx)
    o_lat, _ = chunk_fn(*lat_in, s_ctx, True)
    return (flip(o_ctx) if need_ctx else None), flip(o_lat)


def gated_head_norm(o, gate, w):
    return from_heads(rmsnorm(o, w)) * jax.nn.silu(gate.astype(jnp.float32))


def attention_mixer(h_lat, h_ctx, w_in, rpb, lam, subln, layer, need_ctx):
    b, t, _ = h_lat.shape
    cuts = [NA_W, 2 * NA_W, 3 * NA_W, 3 * NA_W + DF_W, 3 * NA_W + 2 * DF_W]

    def project(h):
        na_q, na_k, na_v, df_q, df_k, df_v = jnp.split(h @ w_in, cuts, axis=-1)
        bh, th, _ = h.shape
        pair = lambda a: a.reshape(bh, th, DIFF_HEADS, 2, DIFF_HEAD_DIM).transpose(0, 2, 3, 1, 4)
        return (to_heads(na_q, NA_HEADS), to_heads(na_k, NA_HEADS), to_heads(na_v, NA_HEADS),
                pair(df_q), pair(df_k), to_heads(df_v, DIFF_HEADS))

    nq, nk, nv, dq, dk, dv = project(h_lat)
    cnq, cnk, cnv, cdq, cdk, cdv = project(h_ctx)
    pos = jnp.arange(t)
    rows, cols = pos // GRID_W, pos % GRID_W
    dq = axial_rope(dq, rows, cols)
    dk = axial_rope(dk, rows, cols)
    lam_init = 0.8 - 0.6 * math.exp(-0.3 * layer)
    lq1, lk1, lq2, lk2 = lam.astype(jnp.float32)
    lam_full = jnp.exp(jnp.sum(lq1 * lk1)) - jnp.exp(jnp.sum(lq2 * lk2)) + lam_init

    def diff_post(o):
        return from_heads(rmsnorm(o, subln) * (1 - lam_init))

    o_na = neighbourhood_attention(nq, nk, nv, cnk, cnv, rpb)
    k_all = jnp.concatenate([cdk, dk], axis=3)
    v_all = jnp.concatenate([cdv, dv], axis=2)
    nb = t // DIFF_BLOCK
    q_blocks = jnp.moveaxis(dq.reshape(b, DIFF_HEADS, 2, nb, DIFF_BLOCK, DIFF_HEAD_DIM), 3, 0)
    o_df = lax.map(lambda qb: diff_attend(qb, k_all, v_all, lam_full), q_blocks)
    o_df = jnp.moveaxis(o_df, 0, 2).reshape(b, DIFF_HEADS, t, 2 * DIFF_HEAD_DIM)
    y_lat = jnp.concatenate([from_heads(o_na), diff_post(o_df)], axis=-1).astype(h_lat.dtype)
    y_ctx = None
    if need_ctx:
        y_ctx = jnp.concatenate([from_heads(softmax_attend(cnq, cnk, cnv)),
                                 diff_post(diff_attend(cdq, cdk, cdv, lam_full))], axis=-1).astype(h_ctx.dtype)
    return y_lat, y_ctx


def recurrent_mixer(h_lat, h_ctx, w_in, lb, conv_w, a_log, dt_bias, c_norm, d_norm, need_ctx):
    f32 = jnp.float32
    cuts = [HG_W, 2 * HG_W, 3 * HG_W, 4 * HG_W, 5 * HG_W, 5 * HG_W + 3 * GD_W, 5 * HG_W + 3 * GD_W + 4 * GDN_HEADS]
    a_rate = jnp.exp(a_log.astype(f32))

    def tokenwise(h):
        hq, hff, hfb, hi, hgate, dqkv, dab, dgate = jnp.split(h @ w_in, cuts, axis=-1)

        def forget(f, lb_dir):
            lb_dir = lb_dir.astype(f32)
            g = jnp.logaddexp(jnp.log(lb_dir), jnp.log1p(-lb_dir) + jax.nn.log_sigmoid(f.astype(f32)))
            return to_heads(-jnp.expm1(g), HGRN_HEADS), to_heads(g, HGRN_HEADS)

        def decay(a, bb, d):
            g = -a_rate[d] * jax.nn.softplus(a + dt_bias[d].astype(f32))
            return jnp.swapaxes(g, 1, 2), jnp.swapaxes(jax.nn.sigmoid(bb), 1, 2)

        qkv = jax.nn.silu(centred_dwconv(dqkv, conv_w)).astype(f32)
        dq, dk, dv = jnp.split(qkv, 3, axis=-1)
        a_f, a_b, b_f, b_b = jnp.split(dab.astype(f32), 4, axis=-1)
        tw = {}
        tw['c_q'] = to_heads(jax.nn.silu(hq.astype(f32)), HGRN_HEADS) * HGRN_HEAD_DIM ** -0.5
        tw['c_v'] = to_heads(hi.astype(f32), HGRN_HEADS)
        tw['c_k_fwd'], tw['c_g_fwd'] = forget(hff, lb[0])
        tw['c_k_bwd'], tw['c_g_bwd'] = forget(hfb, lb[1])
        tw['d_q'] = l2norm(to_heads(dq, GDN_HEADS)) * GDN_HEAD_DIM ** -0.5
        tw['d_k'] = l2norm(to_heads(dk, GDN_HEADS))
        tw['d_v'] = to_heads(dv, GDN_HEADS)
        tw['d_g_fwd'], tw['d_b_fwd'] = decay(a_f, b_f, 0)
        tw['d_g_bwd'], tw['d_b_bwd'] = decay(a_b, b_b, 1)
        tw['c_gate'] = hgate
        tw['d_gate'] = dgate
        return tw

    tl = tokenwise(h_lat)
    tc = tokenwise(h_ctx)
    o_c, o_d = [], []
    for d in ('fwd', 'bwd'):
        rev = d == 'bwd'
        hg_c = (tc['c_q'], tc['c_k_' + d], tc['c_v'], tc['c_g_' + d])
        hg_l = (tl['c_q'], tl['c_k_' + d], tl['c_v'], tl['c_g_' + d])
        gd_c = (tc['d_q'], tc['d_k'], tc['d_v'], tc['d_g_' + d], tc['d_b_' + d])
        gd_l = (tl['d_q'], tl['d_k'], tl['d_v'], tl['d_g_' + d], tl['d_b_' + d])
        o_c.append(directional_scan(gla_chunk, hg_c, hg_l, rev, need_ctx))
        o_d.append(directional_scan(gdn_chunk, gd_c, gd_l, rev, need_ctx))

    def merge(tw, i):
        yc = gated_head_norm(o_c[0][i] + o_c[1][i], tw['c_gate'], c_norm)
        yd = gated_head_norm(o_d[0][i] + o_d[1][i], tw['d_gate'], d_norm)
        return jnp.concatenate([yc, yd], axis=-1)

    y_lat = merge(tl, 1).astype(h_lat.dtype)
    y_ctx = merge(tc, 0).astype(h_ctx.dtype) if need_ctx else None
    return y_lat, y_ctx


def setup_inputs(seed: int = 0) -> dict:
    key = jax.random.key(seed)
    ks = jax.random.split(key, 24)
    f32 = jnp.float32
    D = D_MODEL

    def nrm(k, shape, s):
        return jax.random.normal(k, shape, f32) * s

    def gain(k, shape):
        return 1.0 + 0.05 * jax.random.normal(k, shape, f32)

    dt = jnp.exp(jax.random.uniform(ks[20], (N_REC_LAYERS, 2, GDN_HEADS), f32, math.log(1e-3), math.log(1e-1)))
    return {
        'x': nrm(ks[0], (BATCH, SEQ, D), 1.0),
        'c': nrm(ks[1], (BATCH, D), 1.0),
        'ctx': nrm(ks[2], (BATCH, CTX_LEN, D), 1.0),
        'c_ctx': nrm(ks[3], (D,), 1.0),
        'ada_w': nrm(ks[4], (DEPTH, D, 6 * D), 0.5 * D ** -0.5),
        'ada_b': nrm(ks[5], (DEPTH, 6 * D), 0.01),
        'norm_mix': gain(ks[6], (DEPTH, D)),
        'norm_ffn': gain(ks[7], (DEPTH, D)),
        'w_mix_out': nrm(ks[8], (DEPTH, MIX_W, D), MIX_W ** -0.5),
        'ffn_gate': nrm(ks[9], (DEPTH, D, D_FF), D ** -0.5),
        'ffn_up': nrm(ks[10], (DEPTH, D, D_FF), D ** -0.5),
        'ffn_down': nrm(ks[11], (DEPTH, D_FF, D), D_FF ** -0.5),
        'att_w_in': nrm(ks[12], (N_ATT_LAYERS, D, ATT_IN), D ** -0.5),
        'att_rpb': nrm(ks[13], (N_ATT_LAYERS, NA_HEADS, 2 * NA_WIN_ROWS - 1, 2 * NA_WIN_COLS - 1), 0.02),
        'att_lambda': nrm(ks[14], (N_ATT_LAYERS, 4, DIFF_HEAD_DIM), 0.1),
        'att_subln': gain(ks[15], (N_ATT_LAYERS, 2 * DIFF_HEAD_DIM)),
        'rec_w_in': nrm(ks[16], (N_REC_LAYERS, D, REC_IN), D ** -0.5),
        'rec_lb_logits': nrm(ks[17], (DEPTH, 2, HG_W), 0.1),
        'rec_conv_w': nrm(ks[18], (N_REC_LAYERS, SHORT_CONV, 3 * GD_W), SHORT_CONV ** -0.5),
        'rec_a_log': jnp.log(jax.random.uniform(ks[19], (N_REC_LAYERS, 2, GDN_HEADS), f32, 1.0, 16.0)),
        'rec_dt_bias': dt + jnp.log(-jnp.expm1(-dt)),
        'rec_c_norm': gain(ks[21], (N_REC_LAYERS, HGRN_HEAD_DIM)),
        'rec_d_norm': gain(ks[22], (N_REC_LAYERS, GDN_HEAD_DIM)),
        'final_norm': gain(ks[23], (D,)),
    }


def reference(x, c, ctx, c_ctx, ada_w, ada_b, norm_mix, norm_ffn, w_mix_out, ffn_gate, ffn_up, ffn_down,
              att_w_in, att_rpb, att_lambda, att_subln, rec_w_in, rec_lb_logits, rec_conv_w, rec_a_log,
              rec_dt_bias, rec_c_norm, rec_d_norm, final_norm):
    lbs = jax.nn.softmax(rec_lb_logits.astype(jnp.float32), axis=0)
    lbs = jnp.cumsum(lbs, axis=0) - lbs[0]
    c_lat = c[:, None, :]
    c_pre = c_ctx[None, None, :]
    h_ctx = ctx
    for layer in range(DEPTH):
        last = layer == DEPTH - 1
        j = layer // 2
        mod_l = adaln(c_lat, ada_w[layer], ada_b[layer])
        mod_c = adaln(c_pre, ada_w[layer], ada_b[layer])
        hl = modulate(rmsnorm(x, norm_mix[layer]), mod_l[0], mod_l[1])
        hc = modulate(rmsnorm(h_ctx, norm_mix[layer]), mod_c[0], mod_c[1])
        if layer % 2 == 0:
            y_lat, y_ctx = attention_mixer(hl, hc, att_w_in[j], att_rpb[j], att_lambda[j], att_subln[j],
                                           layer, not last)
        else:
            y_lat, y_ctx = recurrent_mixer(hl, hc, rec_w_in[j], lbs[layer], rec_conv_w[j], rec_a_log[j],
                                           rec_dt_bias[j], rec_c_norm[j], rec_d_norm[j], not last)
        x = x + mod_l[2] * (y_lat @ w_mix_out[layer])
        x = x + mod_l[5] * swiglu(modulate(rmsnorm(x, norm_ffn[layer]), mod_l[3], mod_l[4]),
                                  ffn_gate[layer], ffn_up[layer], ffn_down[layer])
        if not last:
            h_ctx = h_ctx + mod_c[2] * (y_ctx @ w_mix_out[layer])
            h_ctx = h_ctx + mod_c[5] * swiglu(modulate(rmsnorm(h_ctx, norm_ffn[layer]), mod_c[3], mod_c[4]),
                                              ffn_gate[layer], ffn_up[layer], ffn_down[layer])
    return rmsnorm(x, final_norm)
```

```cpp
#include <hip/hip_runtime.h>
#include <hip/hip_cooperative_groups.h>
#include <cstdio>
namespace cg = cooperative_groups;

#define DI __device__ __forceinline__
typedef unsigned short u16;
typedef __attribute__((ext_vector_type(8))) short bf16x8;
typedef __attribute__((ext_vector_type(16))) float f32x16;
typedef __attribute__((ext_vector_type(2))) float f32x2;
typedef __attribute__((ext_vector_type(4))) unsigned u32x4;
typedef __attribute__((ext_vector_type(2))) unsigned u32x2;
#define MFMA32(a, b, c) __builtin_amdgcn_mfma_f32_32x32x16_bf16((a), (b), (c), 0, 0, 0)

#ifndef ONE_LAUNCH
#define ONE_LAUNCH 1
#endif

constexpr int NB = 4, SEQ = 8192, CTX = 256, UB = 8448, MROWS = 33792, DM = 1024, DFF = 2816;
constexpr int NPROJ = 4608;
constexpr float LOG2E = 1.4426950408889634f;
constexpr float EPS = 1e-6f;

constexpr size_t SZ_W_ATT = (size_t)3072 * 1024 * 2;
constexpr size_t SZ_W_REC = (size_t)4864 * 1024 * 2;
constexpr size_t SZ_W_MIX = (size_t)2 * 1024 * 1024 * 2;
constexpr size_t SZ_W_GU = (size_t)2 * 5632 * 1024 * 2;
constexpr size_t SZ_W_DN = (size_t)2 * 1024 * 2816 * 2;
constexpr size_t OFF_W_ATT = 0;
constexpr size_t OFF_W_REC = OFF_W_ATT + SZ_W_ATT;
constexpr size_t OFF_W_MIX = OFF_W_REC + SZ_W_REC;
constexpr size_t OFF_W_GU = OFF_W_MIX + SZ_W_MIX;
constexpr size_t OFF_W_DN = OFF_W_GU + SZ_W_GU;
constexpr size_t OFF_MOD = OFF_W_DN + SZ_W_DN;
constexpr size_t OFF_ROPE = OFF_MOD + (size_t)2 * 5 * 6144 * 4;
constexpr size_t OFF_MISC = OFF_ROPE + 128 * 16 * 2 * 4;
constexpr size_t OFF_BAR = OFF_MISC + 8192;
constexpr size_t OFF_XCTX = OFF_BAR + 16384;
constexpr size_t OFF_DAB = OFF_XCTX + (size_t)1024 * 1024 * 4;
constexpr size_t OFF_H = OFF_DAB + (size_t)MROWS * 16 * 4;
constexpr size_t OFF_OB = OFF_H + (size_t)MROWS * 1024 * 2;
constexpr size_t OFF_BIG = OFF_OB + (size_t)MROWS * 1024 * 2;
constexpr size_t OFF_VT = OFF_BIG + (size_t)MROWS * 2048 * 2;
constexpr size_t WS_TOTAL = OFF_BIG + (size_t)MROWS * NPROJ * 2;
constexpr int NSEG_G = 8, SEGC_G = 33, NHO_G = NSEG_G - 1;
constexpr int NSEG_H = 3, SEGC_H = 88, NHO_H = NSEG_H - 1;
constexpr size_t OFF_GS = OFF_W_ATT;
constexpr size_t OFF_HD = OFF_GS + (size_t)32 * NHO_G * 16384 * 4;
constexpr size_t OFF_GP = OFF_W_GU;
constexpr size_t OFF_HS = OFF_GP + (size_t)32 * NHO_G * 16384 * 2;
static_assert(OFF_HD + 32 * NHO_H * 128 * 4 <= OFF_W_MIX, "gdn states must fit in the dead att/rec weight region");
static_assert(OFF_HS + (size_t)32 * NHO_H * 16384 * 4 <= OFF_W_GU + SZ_W_GU / 2, "transitions + HGRN states must fit in layer-0 gate/up");
constexpr size_t WS_NEED = WS_TOTAL;

struct Params {
  const float *x, *c, *ctx, *c_ctx, *ada_w, *ada_b, *norm_mix, *norm_ffn, *w_mix_out, *ffn_gate, *ffn_up, *ffn_down,
      *att_w_in, *att_rpb, *att_lambda, *att_subln, *rec_w_in, *rec_lb_logits, *rec_conv_w, *rec_a_log, *rec_dt_bias,
      *rec_c_norm, *rec_d_norm, *final_norm;
  float* out;
  char* ws;
  int ph_lo, ph_hi;
};

DI u16 f2bf(float x) {
  unsigned u = __float_as_uint(x);
  u += 0x7fffu + ((u >> 16) & 1u);
  return (u16)(u >> 16);
}
DI float bf2f(u16 v) { return __uint_as_float(((unsigned)v) << 16); }
typedef __attribute__((ext_vector_type(2))) __bf16 bf16x2_t;
DI unsigned pack2(float a, float b) {
  f32x2 v = {a, b};
  return __builtin_bit_cast(unsigned, __builtin_convertvector(v, bf16x2_t));
}
DI float bflo(unsigned u) { return __uint_as_float(u << 16); }
DI float bfhi(unsigned u) { return __uint_as_float(u & 0xffff0000u); }
DI int crow(int reg, int h) { return (reg & 3) + 8 * (reg >> 2) + 4 * h; }
DI float sigmoidf_(float x) { return __builtin_amdgcn_rcpf(1.f + __expf(-x)); }
DI float siluf_(float x) { return x * __builtin_amdgcn_rcpf(1.f + __expf(-x)); }
DI float wave_sum(float v) {
#pragma unroll
  for (int o = 32; o > 0; o >>= 1) v += __shfl_xor(v, o);
  return v;
}
template <int CTRL>
DI float dpp_mov(float x) {
  return __builtin_bit_cast(float, __builtin_amdgcn_update_dpp(0, __builtin_bit_cast(int, x), CTRL, 0xF, 0xF, true));
}
DI float dpp_sum8(float x) {
  x += dpp_mov<0xB1>(x);
  x += dpp_mov<0x4E>(x);
  x += dpp_mov<0x141>(x);
  return x;
}
DI float dpp_sum16(float x) {
  x = dpp_sum8(x);
  x += dpp_mov<0x140>(x);
  return x;
}
DI void my_sincos(float a, float& s, float& c) {
  float q = rintf(a * 0.636619772f);
  float r = fmaf(-q, 1.57079637f, a);
  r = fmaf(-q, -4.37113883e-8f, r);
  int qi = ((int)q) & 3;
  float r2 = r * r;
  float sr = r + r * r2 * (-1.6666654611e-1f + r2 * (8.3321608736e-3f + r2 * (-1.9515295891e-4f)));
  float cr = 1.f - 0.5f * r2 + r2 * r2 * (4.166664568298827e-2f + r2 * (-1.388731625493765e-3f + r2 * 2.443315711809948e-5f));
  if (qi == 0) { s = sr; c = cr; }
  else if (qi == 1) { s = cr; c = -sr; }
  else if (qi == 2) { s = -sr; c = -cr; }
  else { s = -cr; c = sr; }
}
DI f32x16 zero16() {
  f32x16 z;
#pragma unroll
  for (int i = 0; i < 16; ++i) z[i] = 0.f;
  return z;
}
DI const float* row_in(const Params& p, int u) {
  int b = u / UB, uu = u - b * UB;
  return uu < CTX ? p.ctx + ((size_t)b * CTX + uu) * DM : p.x + ((size_t)b * SEQ + (uu - CTX)) * DM;
}
DI float* row_cur(const Params& p, int u) {
  int b = u / UB, uu = u - b * UB;
  return uu < CTX ? (float*)(p.ws + OFF_XCTX) + ((size_t)b * CTX + uu) * DM : p.out + ((size_t)b * SEQ + (uu - CTX)) * DM;
}
DI int mod_vec(int u) {
  int b = u / UB, uu = u - b * UB;
  return uu < CTX ? 4 : b;
}

#define XB_TMO      128
#define XB_XCNT(j)  (256  + 64 * (j))
#define XB_XSUB(j)  (1280 + 64 * (j))
#define XB_XGEN(j)  (2304 + 64 * (j))
#define XB_TOP      3328
#define XB_TOPGEN   3392
#define XCD_BAR_WORDS 3456
#define XB_SPIN_CAP (1u << 18)
#define LAS __attribute__((address_space(3)))
DI unsigned xb_ld(unsigned* p) { return __hip_atomic_load(p, __ATOMIC_RELAXED, __HIP_MEMORY_SCOPE_AGENT); }
DI unsigned xb_add(unsigned* p, unsigned v) { return __hip_atomic_fetch_add(p, v, __ATOMIC_RELAXED, __HIP_MEMORY_SCOPE_AGENT); }
DI unsigned xb_xcc_id() { return (unsigned)__builtin_amdgcn_s_getreg((3 << 11) | 20) & 0xFu; }
#define XB_SPIN(cond, bar) do { unsigned _sp = 0; while (cond) { __builtin_amdgcn_s_sleep(1); \
    if ((++_sp & 255u) == 0u) { if (xb_ld(&(bar)[XB_TMO])) break; if (_sp > XB_SPIN_CAP) { atomicAdd(&(bar)[XB_TMO], 1u); break; } } } } while (0)
struct XcdBarrier {
  unsigned* bar;
  unsigned x;
  volatile LAS unsigned* st;
};
DI XcdBarrier xcd_barrier_post(unsigned* bar, volatile LAS unsigned* st) {
  XcdBarrier b;
  b.bar = bar; b.x = xb_xcc_id(); b.st = st;
  if (threadIdx.x == 0) (void)xb_add(&bar[XB_XCNT(b.x)], 1u);
  return b;
}
DI void xcd_barrier_complete(unsigned* bar, unsigned x, unsigned& nloc, unsigned& nx) {
  const unsigned G = gridDim.x * gridDim.y * gridDim.z;
  unsigned sum, cnt, mine, sp = 0u;
  for (;;) {
    sum = 0u; cnt = 0u; mine = 0u;
#pragma unroll
    for (unsigned j = 0; j < 16; ++j) {
      const unsigned c = xb_ld(&bar[XB_XCNT(j)]);
      sum += c; cnt += (c > 0u) ? 1u : 0u; mine = (j == x) ? c : mine;
    }
    if (sum == G) break;
    __builtin_amdgcn_s_sleep(1);
    if ((++sp & 255u) == 0u) { if (xb_ld(&bar[XB_TMO])) break; if (sp > XB_SPIN_CAP) { atomicAdd(&bar[XB_TMO], 1u); break; } }
  }
  nloc = mine > 0u ? mine : 1u; nx = cnt > 0u ? cnt : 1u;
}
DI void xcd_barrier(const XcdBarrier& b) {
  asm volatile("s_waitcnt vmcnt(0)" ::: "memory");
  __syncthreads();
  if (threadIdx.x == 0) {
    unsigned* bar = b.bar;
    __builtin_amdgcn_s_waitcnt(0);
    unsigned nloc = b.st[0], nx = b.st[1];
    if (nloc == 0u) { xcd_barrier_complete(bar, b.x, nloc, nx); b.st[0] = nloc; b.st[1] = nx; }
    const unsigned old = xb_add(&bar[XB_XSUB(b.x)], 1u);
    const unsigned gen = old / nloc;
    if (old + 1u == (gen + 1u) * nloc) {
      __builtin_amdgcn_fence(__ATOMIC_RELEASE, "agent");
      asm volatile("s_waitcnt vmcnt(0)" ::: "memory");
      const unsigned og = xb_add(&bar[XB_TOP], 1u);
      const unsigned tg = og / nx;
      if (og + 1u == (tg + 1u) * nx) xb_add(&bar[XB_TOPGEN], 1u);
      else XB_SPIN(xb_ld(&bar[XB_TOPGEN]) == tg, bar);
      __builtin_amdgcn_fence(__ATOMIC_ACQUIRE, "agent");
      xb_add(&bar[XB_XGEN(b.x)], 1u);
      asm volatile("s_waitcnt vmcnt(0)" ::: "memory");
    } else {
      XB_SPIN(xb_ld(&bar[XB_XGEN(b.x)]) == gen, bar);
      __builtin_amdgcn_fence(__ATOMIC_ACQUIRE, "agent");
      asm volatile("s_waitcnt vmcnt(0)" ::: "memory");
    }
  }
  __syncthreads();
}

template <class F>
DI void conv_tile(float* tile, int k0, int n0, int K, u16* __restrict__ dst, F srcf) {
  const int tid = threadIdx.x;
#pragma unroll 4
  for (int i = 0; i < 16; ++i) {
    int idx = i * 256 + tid, kk = idx >> 6, nn = idx & 63;
    tile[kk * 65 + nn] = srcf(k0 + kk, n0 + nn);
  }
  __syncthreads();
#pragma unroll 4
  for (int i = 0; i < 8; ++i) {
    int idx = i * 256 + tid, nn = idx >> 5, kk = (idx & 31) * 2;
    *(unsigned*)(dst + (size_t)(n0 + nn) * K + k0 + kk) = pack2(tile[kk * 65 + nn], tile[(kk + 1) * 65 + nn]);
  }
  __syncthreads();
}

DI void phase_prep(const Params& p, char* smem) {
  const int tid = threadIdx.x;
  float* fs = (float*)smem;
  const int N_CONV = 768 + 1216 + 512 + 2816 + 1408;
  const int N_ITEMS = N_CONV + 192 + 1;
  for (int item = blockIdx.x; item < N_ITEMS; item += gridDim.x) {
    if (item < 768) {
      int kt = item / 48, nt = item % 48;
      const float* src = p.att_w_in;
      conv_tile(fs, kt * 64, nt * 64, 1024, (u16*)(p.ws + OFF_W_ATT), [&](int k, int n) {
        int seg = n >> 9;
        int sseg = seg == 2 ? 3 : seg == 3 ? 4 : seg == 4 ? 2 : seg;
        return src[(size_t)k * 3072 + sseg * 512 + (n & 511)];
      });
    } else if (item < 768 + 1216) {
      int it = item - 768, kt = it / 76, nt = it % 76;
      const float* src = p.rec_w_in;
      conv_tile(fs, kt * 64, nt * 64, 1024, (u16*)(p.ws + OFF_W_REC),
                [&](int k, int n) { return n < 4624 ? src[(size_t)k * 4624 + n] : 0.f; });
    } else if (item < 768 + 1216 + 512) {
      int it = item - 1984, l = it / 256, r = it % 256, kt = r / 16, nt = r % 16;
      const float* src = p.w_mix_out + (size_t)l * 1024 * 1024;
      conv_tile(fs, kt * 64, nt * 64, 1024, (u16*)(p.ws + OFF_W_MIX) + (size_t)l * 1024 * 1024,
                [&](int k, int n) { return src[(size_t)k * 1024 + n]; });
    } else if (item < 768 + 1216 + 512 + 2816) {
      int it = item - 2496, l = it / 1408, r = it % 1408, kt = r / 88, nt = r % 88;
      const float* sg = p.ffn_gate + (size_t)l * 1024 * DFF;
      const float* su = p.ffn_up + (size_t)l * 1024 * DFF;
      conv_tile(fs, kt * 64, nt * 64, 1024, (u16*)(p.ws + OFF_W_GU) + (size_t)l * 5632 * 1024, [&](int k, int n) {
        int blk = n >> 6, r6 = n & 63;
        return r6 < 32 ? sg[(size_t)k * DFF + blk * 32 + r6] : su[(size_t)k * DFF + blk * 32 + r6 - 32];
      });
    } else if (item < N_CONV) {
      int it = item - 5312, l = it / 704, r = it % 704, kt = r / 16, nt = r % 16;
      const float* src = p.ffn_down + (size_t)l * DFF * 1024;
      conv_tile(fs, kt * 64, nt * 64, DFF, (u16*)(p.ws + OFF_W_DN) + (size_t)l * 1024 * DFF,
                [&](int k, int n) { return src[(size_t)k * 1024 + n]; });
    } else if (item < N_CONV + 192) {
      int it = item - N_CONV, l = it / 96, cb = it % 96;
      float* s = fs;
      float* red = fs + 5 * 1024;
      for (int i = tid; i < 5 * 1024; i += 256) {
        int v = i >> 10, k = i & 1023;
        float cv = v < 4 ? p.c[v * 1024 + k] : p.c_ctx[k];
        s[i] = siluf_(cv);
      }
      __syncthreads();
      int ci = tid & 63, kg = tid >> 6, col = cb * 64 + ci;
      float acc[5] = {0.f, 0.f, 0.f, 0.f, 0.f};
      const float* w = p.ada_w + (size_t)l * 1024 * 6144 + col;
      for (int k = kg; k < 1024; k += 4) {
        float wv = w[(size_t)k * 6144];
#pragma unroll
        for (int v = 0; v < 5; ++v) acc[v] += s[v * 1024 + k] * wv;
      }
#pragma unroll
      for (int v = 0; v < 5; ++v) red[(kg * 5 + v) * 64 + ci] = acc[v];
      __syncthreads();
      if (kg == 0) {
        float* mod = (float*)(p.ws + OFF_MOD);
#pragma unroll
        for (int v = 0; v < 5; ++v) {
          float t = red[(0 * 5 + v) * 64 + ci] + red[(1 * 5 + v) * 64 + ci] + red[(2 * 5 + v) * 64 + ci] + red[(3 * 5 + v) * 64 + ci];
          mod[(size_t)(l * 5 + v) * 6144 + col] = t + p.ada_b[l * 6144 + col];
        }
      }
      __syncthreads();
    } else {
      float* rope = (float*)(p.ws + OFF_ROPE);
      float* misc = (float*)(p.ws + OFF_MISC);
      for (int i = tid; i < 128 * 16; i += 256) {
        int pos = i >> 4, fi = i & 15;
        float invf = exp2f(-(float)fi * (13.287712379549449f / 16.f));
        float s, c;
        my_sincos((float)pos * invf, s, c);
        rope[i * 2] = c;
        rope[i * 2 + 1] = s;
      }
      for (int i = tid; i < 1024; i += 256) {
        float l0 = p.rec_lb_logits[i], l1 = p.rec_lb_logits[1024 + i];
        misc[16 + i] = 1.f / (1.f + expf(l0 - l1));
      }
      if (tid < 64) {
        float a = p.att_lambda[tid] * p.att_lambda[64 + tid];
        float b = p.att_lambda[128 + tid] * p.att_lambda[192 + tid];
        a = wave_sum(a);
        b = wave_sum(b);
        if (tid == 0) misc[0] = expf(a) - expf(b) + 0.2f;
      }
    }
  }
}

DI void norm_row(const float* __restrict__ src, const float* __restrict__ w, const float* __restrict__ shift,
                 const float* __restrict__ scale, u16* __restrict__ dst, int lane) {
  float4 v[4];
  float ss = 0.f;
#pragma unroll
  for (int i = 0; i < 4; ++i) {
    v[i] = ((const float4*)src)[lane + i * 64];
    ss += v[i].x * v[i].x + v[i].y * v[i].y + v[i].z * v[i].z + v[i].w * v[i].w;
  }
  ss = wave_sum(ss);
  float rs = rsqrtf(ss * (1.f / 1024.f) + EPS);
#pragma unroll
  for (int i = 0; i < 4; ++i) {
    int c4 = lane + i * 64;
    float4 ww = ((const float4*)w)[c4], sh = ((const float4*)shift)[c4], sc = ((const float4*)scale)[c4];
    float a = v[i].x * rs * ww.x * (1.f + sc.x) + sh.x;
    float b = v[i].y * rs * ww.y * (1.f + sc.y) + sh.y;
    float c = v[i].z * rs * ww.z * (1.f + sc.z) + sh.z;
    float d = v[i].w * rs * ww.w * (1.f + sc.w) + sh.w;
    uint2 o;
    o.x = pack2(a, b);
    o.y = pack2(c, d);
    ((uint2*)dst)[c4] = o;
  }
}
DI void phase_norm(const Params& p, int layer, int which, bool skip_ctx) {
  const int lane = threadIdx.x & 63, wave = threadIdx.x >> 6;
  const float* mod = (const float*)(p.ws + OFF_MOD);
  u16* H = (u16*)(p.ws + OFF_H);
  for (int item = blockIdx.x; item < MROWS / 4; item += gridDim.x) {
    int u = item * 4 + wave;
    int uu = u % UB;
    if (skip_ctx && uu < CTX) continue;
    const float* src = (which == 0) ? row_in(p, u) : row_cur(p, u);
    const float* w = (which == 1 ? p.norm_ffn : p.norm_mix) + layer * 1024;
    const float* mv = mod + (size_t)(layer * 5 + mod_vec(u)) * 6144 + (which == 1 ? 3 * 1024 : 0);
    norm_row(src, w, mv, mv + 1024, H + (size_t)u * 1024, lane);
  }
}
DI void phase_final(const Params& p) {
  const int lane = threadIdx.x & 63, wave = threadIdx.x >> 6;
  for (int item = blockIdx.x; item < NB * SEQ / 4; item += gridDim.x) {
    float* row = p.out + (size_t)(item * 4 + wave) * 1024;
    float4 v[4];
    float ss = 0.f;
#pragma unroll
    for (int i = 0; i < 4; ++i) {
      v[i] = ((const float4*)row)[lane + i * 64];
      ss += v[i].x * v[i].x + v[i].y * v[i].y + v[i].z * v[i].z + v[i].w * v[i].w;
    }
    ss = wave_sum(ss);
    float rs = rsqrtf(ss * (1.f / 1024.f) + EPS);
#pragma unroll
    for (int i = 0; i < 4; ++i) {
      float4 ww = ((const float4*)p.final_norm)[lane + i * 64];
      float4 o;
      o.x = v[i].x * rs * ww.x; o.y = v[i].y * rs * ww.y; o.z = v[i].z * rs * ww.z; o.w = v[i].w * rs * ww.w;
      ((float4*)row)[lane + i * 64] = o;
    }
  }
}

DI bool gemm_tile_of(int it, int NT, int& mt, int& nt) {
  if ((gridDim.x & 7) != 0) {
    int item = it * gridDim.x + blockIdx.x;
    if (item >= 264 * NT) return false;
    mt = item / NT; nt = item % NT;
    return true;
  }
  const int xcd = blockIdx.x & 7, lw = blockIdx.x >> 3, wpx = gridDim.x >> 3;
  int idx = it * wpx + lw;
  if (idx >= 33 * NT) return false;
  const int nfull = NT >> 3, full_items = nfull * 33 * 8;
  int ml;
  if (idx < full_items) {
    int nb = idx / 264, rem = idx - nb * 264;
    ml = rem >> 3; nt = nb * 8 + (rem & 7);
  } else {
    int i2 = idx - full_items, w = NT - nfull * 8;
    ml = i2 / w; nt = nfull * 8 + (i2 - ml * w);
  }
  mt = xcd * 33 + ml;
  return true;
}

DI void gemm_core(const u16* __restrict__ A, int lda, const u16* __restrict__ Wt, int K, int m0, int n0, char* smem,
                  f32x16 (&acc)[2][2]) {
  u16* As = (u16*)smem;
  u16* Bs = As + 2 * 128 * 72;
  const int tid = threadIdx.x, lane = tid & 63, wave = tid >> 6;
  const int wm = (wave >> 1) * 64, wn = (wave & 1) * 64;
  const int r = lane & 31, h = lane >> 5;
#pragma unroll
  for (int i = 0; i < 2; ++i)
#pragma unroll
    for (int j = 0; j < 2; ++j) acc[i][j] = zero16();
  u32x4 ra0[4], rb0[4], ra1[4], rb1[4];
  const int lrow = tid >> 3, lcc = (tid & 7) * 8;
  const u16* ag = A + (size_t)(m0 + lrow) * lda + lcc;
  const u16* bg = Wt + (size_t)(n0 + lrow) * K + lcc;
  const int nk = K >> 6;
#define GLOAD(RA, RB, KT)                                                   \
  _Pragma("unroll") for (int i = 0; i < 4; ++i) {                           \
    RA[i] = *(const u32x4*)(ag + (size_t)(i * 32) * lda + (KT) * 64);       \
    RB[i] = *(const u32x4*)(bg + (size_t)(i * 32) * K + (KT) * 64);         \
  }
#define SSTORE(RA, RB, BUF)                                                 \
  _Pragma("unroll") for (int i = 0; i < 4; ++i) {                           \
    *(u32x4*)(As + (BUF) * 128 * 72 + (lrow + i * 32) * 72 + lcc) = RA[i];  \
    *(u32x4*)(Bs + (BUF) * 128 * 72 + (lrow + i * 32) * 72 + lcc) = RB[i];  \
  }
#define COMPUTE(BUF)                                                                        \
  _Pragma("unroll") for (int ks = 0; ks < 4; ++ks) {                                        \
    const u16* as = As + (BUF) * 128 * 72;                                                  \
    const u16* bs = Bs + (BUF) * 128 * 72;                                                  \
    bf16x8 a0 = *(const bf16x8*)(as + (wm + r) * 72 + ks * 16 + h * 8);                     \
    bf16x8 a1 = *(const bf16x8*)(as + (wm + 32 + r) * 72 + ks * 16 + h * 8);                \
    bf16x8 b0 = *(const bf16x8*)(bs + (wn + r) * 72 + ks * 16 + h * 8);                     \
    bf16x8 b1 = *(const bf16x8*)(bs + (wn + 32 + r) * 72 + ks * 16 + h * 8);                \
    acc[0][0] = MFMA32(a0, b0, acc[0][0]);                                                  \
    acc[0][1] = MFMA32(a0, b1, acc[0][1]);                                                  \
    acc[1][0] = MFMA32(a1, b0, acc[1][0]);                                                  \
    acc[1][1] = MFMA32(a1, b1, acc[1][1]);                                                  \
  }
  GLOAD(ra0, rb0, 0)
  GLOAD(ra1, rb1, 1)
  __syncthreads();
  SSTORE(ra0, rb0, 0)
  __syncthreads();
  if (nk > 2) { GLOAD(ra0, rb0, 2) }
  for (int it = 0; it < nk; it += 2) {
    COMPUTE(0)
    SSTORE(ra1, rb1, 1)
    __syncthreads();
    if (it + 3 < nk) { GLOAD(ra1, rb1, it + 3) }
    COMPUTE(1)
    if (it + 2 < nk) { SSTORE(ra0, rb0, 0) }
    __syncthreads();
    if (it + 4 < nk) { GLOAD(ra0, rb0, it + 4) }
  }
#undef GLOAD
#undef SSTORE
#undef COMPUTE
}

DI void gemm_core256(const u16* __restrict__ A, int lda, const u16* __restrict__ Wt, int K, int m0, int n0, char* smem,
                     f32x16 (&acc)[2][4]) {
  constexpr int PT = 40;
  u16* As = (u16*)smem;
  u16* Bs = As + 2 * 128 * PT;
  const int tid = threadIdx.x, lane = tid & 63, wave = tid >> 6;
  const int wm = (wave >> 1) * 64, wn = (wave & 1) * 128;
  const int r = lane & 31, h = lane >> 5;
#pragma unroll
  for (int i = 0; i < 2; ++i)
#pragma unroll
    for (int j = 0; j < 4; ++j) acc[i][j] = zero16();
  u32x4 ra0[2], rb0[4], ra1[2], rb1[4];
  const int lrow = tid >> 2, lcc = (tid & 3) * 8;
  const u16* ag = A + (size_t)(m0 + lrow) * lda + lcc;
  const u16* bg = Wt + (size_t)(n0 + lrow) * K + lcc;
  const int nk = K >> 5;
#define GLOAD(RA, RB, KT)                                                                          \
  _Pragma("unroll") for (int i = 0; i < 2; ++i) RA[i] = *(const u32x4*)(ag + (size_t)(i * 64) * lda + (KT) * 32); \
  _Pragma("unroll") for (int i = 0; i < 4; ++i) RB[i] = *(const u32x4*)(bg + (size_t)(i * 64) * K + (KT) * 32);
#define SSTORE(RA, RB, BUF)                                                                        \
  _Pragma("unroll") for (int i = 0; i < 2; ++i) *(u32x4*)(As + (BUF) * 128 * PT + (lrow + i * 64) * PT + lcc) = RA[i]; \
  _Pragma("unroll") for (int i = 0; i < 4; ++i) *(u32x4*)(Bs + (BUF) * 256 * PT + (lrow + i * 64) * PT + lcc) = RB[i];
#define COMPUTE(BUF)                                                                               \
  _Pragma("unroll") for (int ks = 0; ks < 2; ++ks) {                                               \
    const u16* as = As + (BUF) * 128 * PT;                                                         \
    const u16* bs = Bs + (BUF) * 256 * PT;                                                         \
    bf16x8 a0 = *(const bf16x8*)(as + (wm + r) * PT + ks * 16 + h * 8);                            \
    bf16x8 a1 = *(const bf16x8*)(as + (wm + 32 + r) * PT + ks * 16 + h * 8);                       \
    _Pragma("unroll") for (int j = 0; j < 4; ++j) {                                                \
      bf16x8 bj = *(const bf16x8*)(bs + (wn + 32 * j + r) * PT + ks * 16 + h * 8);                 \
      acc[0][j] = MFMA32(a0, bj, acc[0][j]);                                                       \
      acc[1][j] = MFMA32(a1, bj, acc[1][j]);                                                       \
    }                                                                                              \
  }
  GLOAD(ra0, rb0, 0)
  GLOAD(ra1, rb1, 1)
  __syncthreads();
  SSTORE(ra0, rb0, 0)
  __syncthreads();
  if (nk > 2) { GLOAD(ra0, rb0, 2) }
  for (int it = 0; it < nk; it += 2) {
    COMPUTE(0)
    SSTORE(ra1, rb1, 1)
    __syncthreads();
    if (it + 3 < nk) { GLOAD(ra1, rb1, it + 3) }
    COMPUTE(1)
    if (it + 2 < nk) { SSTORE(ra0, rb0, 0) }
    __syncthreads();
    if (it + 4 < nk) { GLOAD(ra0, rb0, it + 4) }
  }
#undef GLOAD
#undef SSTORE
#undef COMPUTE
}

DI void phase_gemm_att_in(const Params& p, char* smem) {
  const u16* H = (const u16*)(p.ws + OFF_H);
  const u16* W = (const u16*)(p.ws + OFF_W_ATT);
  u16* QK = (u16*)(p.ws + OFF_BIG);
  u16* VT = (u16*)(p.ws + OFF_VT);
  const float* rope = (const float*)(p.ws + OFF_ROPE);
  const int lane = threadIdx.x & 63, wave = threadIdx.x >> 6;
  const int wm = (wave >> 1) * 64, wn = (wave & 1) * 64, r = lane & 31, h = lane >> 5;
  const int NT = 24, MT = MROWS / 128;
  for (int it = 0;; ++it) {
    int mt, nt;
    if (!gemm_tile_of(it, NT, mt, nt)) break;
    int m0 = mt * 128, n0 = nt * 128;
    f32x16 acc[2][2];
    gemm_core(H, 1024, W, 1024, m0, n0, smem, acc);
    int seg = n0 >> 9;
    int b = m0 / UB, uu0 = m0 - b * UB;
    bool lat = uu0 >= CTX;
    if (seg < 4) {
      bool dorope = lat && seg >= 2;
#pragma unroll
      for (int i = 0; i < 2; ++i)
#pragma unroll
        for (int j = 0; j < 2; ++j) {
          int n = n0 + wn + 32 * j + r;
#pragma unroll
          for (int g = 0; g < 16; ++g) {
            int mrow = m0 + wm + 32 * i + crow(g, h);
            float v = acc[i][j][g];
            if (seg >= 2) {
              float pv = __shfl_xor(v, 16);
              if (dorope) {
                int t = uu0 + wm + 32 * i + crow(g, h) - CTX;
                int pos = (j == 0) ? (t >> 6) : (t & 63);
                float2 cs = ((const float2*)rope)[pos * 16 + (r & 15)];
                v = v * cs.x + ((r < 16) ? -pv : pv) * cs.y;
              }
            }
            QK[(size_t)mrow * 2048 + n] = f2bf(v);
          }
        }
    } else {
#pragma unroll
      for (int i = 0; i < 2; ++i)
#pragma unroll
        for (int j = 0; j < 2; ++j) {
          int vc = n0 - 2048 + wn + 32 * j + r;
          u16* vrow = VT + ((size_t)b * 1024 + vc) * UB;
#pragma unroll
          for (int g4 = 0; g4 < 4; ++g4) {
            int tok = uu0 + wm + 32 * i + 8 * g4 + 4 * h;
            uint2 o;
            o.x = pack2(acc[i][j][4 * g4], acc[i][j][4 * g4 + 1]);
            o.y = pack2(acc[i][j][4 * g4 + 2], acc[i][j][4 * g4 + 3]);
            *(uint2*)(vrow + tok) = o;
          }
        }
    }
  }
}

DI void phase_gemm_resid(const Params& p, char* smem, const u16* A, int lda, const u16* W, int K, int layer, int gate_chunk,
                         bool first, bool skip_ctx) {
  const float* mod = (const float*)(p.ws + OFF_MOD);
  const int lane = threadIdx.x & 63, wave = threadIdx.x >> 6;
  const int wm = (wave >> 1) * 64, wn = (wave & 1) * 64, r = lane & 31, h = lane >> 5;
  const int NT = 8, MT = MROWS / 128;
  for (int it = 0;; ++it) {
    int mt, nt;
    if (!gemm_tile_of(it, NT, mt, nt)) break;
    if (skip_ctx && (mt % 66) < 2) continue;
    int m0 = mt * 128, n0 = nt * 128;
    f32x16 acc[2][2];
    gemm_core(A, lda, W, K, m0, n0, smem, acc);
    const float* gv = mod + (size_t)(layer * 5 + mod_vec(m0)) * 6144 + gate_chunk * 1024;
    const float* src0 = (first ? row_in(p, m0) : row_cur(p, m0)) + n0 + wn + r;
    float* dst0 = row_cur(p, m0) + n0 + wn + r;
    const float g0 = gv[n0 + wn + r], g1 = gv[n0 + wn + 32 + r];
    int hq = h;
    asm volatile("" : "+v"(hq));
#pragma unroll
    for (int i = 0; i < 2; ++i)
#pragma unroll
      for (int g = 0; g < 16; ++g) {
        const int ro = (wm + 32 * i + crow(g, hq)) * 1024;
        dst0[ro] = src0[ro] + g0 * acc[i][0][g];
        dst0[ro + 32] = src0[ro + 32] + g1 * acc[i][1][g];
      }
  }
}

DI void phase_gemm_gu(const Params& p, char* smem, int layer, bool skip_ctx) {
  const u16* H = (const u16*)(p.ws + OFF_H);
  const u16* W = (const u16*)(p.ws + OFF_W_GU) + (size_t)layer * 5632 * 1024;
  u16* ACT = (u16*)(p.ws + OFF_BIG);
  const int lane = threadIdx.x & 63, wave = threadIdx.x >> 6;
  const int wm = (wave >> 1) * 64, wn = (wave & 1) * 128, r = lane & 31, h = lane >> 5;
  const int NT = 22;
  for (int it = 0;; ++it) {
    int mt, nt;
    if (!gemm_tile_of(it, NT, mt, nt)) break;
    if (skip_ctx && (mt % 66) < 2) continue;
    int m0 = mt * 128, n0 = nt * 256;
    f32x16 acc[2][4];
    gemm_core256(H, 1024, W, 1024, m0, n0, smem, acc);
    int col = ((n0 + wn) >> 1) + r;
#pragma unroll
    for (int i = 0; i < 2; ++i)
#pragma unroll
      for (int g = 0; g < 16; ++g) {
        int mrow = m0 + wm + 32 * i + crow(g, h);
        ACT[(size_t)mrow * DFF + col] = f2bf(siluf_(acc[i][0][g]) * acc[i][1][g]);
        ACT[(size_t)mrow * DFF + col + 32] = f2bf(siluf_(acc[i][2][g]) * acc[i][3][g]);
      }
  }
}

DI void phase_gemm_rec_in(const Params& p, char* smem) {
  const u16* H = (const u16*)(p.ws + OFF_H);
  const u16* W = (const u16*)(p.ws + OFF_W_REC);
  u16* PROJ = (u16*)(p.ws + OFF_BIG);
  float* DAB = (float*)(p.ws + OFF_DAB);
  const int lane = threadIdx.x & 63, wave = threadIdx.x >> 6;
  const int wm = (wave >> 1) * 64, wn = (wave & 1) * 128, r = lane & 31, h = lane >> 5;
  const int NT = 19;
  for (int it = 0;; ++it) {
    int mt, nt;
    if (!gemm_tile_of(it, NT, mt, nt)) break;
    int m0 = mt * 128, n0 = nt * 256;
    f32x16 acc[2][4];
    gemm_core256(H, 1024, W, 1024, m0, n0, smem, acc);
#pragma unroll
    for (int i = 0; i < 2; ++i)
#pragma unroll
      for (int j = 0; j < 4; ++j) {
        int n = n0 + wn + 32 * j + r;
#pragma unroll
        for (int g = 0; g < 16; ++g) {
          int mrow = m0 + wm + 32 * i + crow(g, h);
          float v = acc[i][j][g];
          if (n < 4096) PROJ[(size_t)mrow * NPROJ + n] = f2bf(v);
          else if (n >= 4112 && n < 4624) PROJ[(size_t)mrow * NPROJ + n - 16] = f2bf(v);
        }
      }
    if (n0 + wn == 4096 && r < 16) {
      const float dtb = p.rec_dt_bias[r & 7], ar = expf(p.rec_a_log[r & 7]);
#pragma unroll
      for (int i = 0; i < 2; ++i)
#pragma unroll
        for (int g = 0; g < 16; ++g) {
          const int mrow = m0 + wm + 32 * i + crow(g, h);
          const float v = acc[i][0][g];
          float o;
          if (r < 8) {
            const float xx = v + dtb;
            const float sp = xx > 20.f ? xx : log1pf(expf(xx));
            o = -ar * sp;
          } else {
            o = 1.f / (1.f + expf(-v));
          }
          DAB[(size_t)mrow * 16 + r] = o;
        }
    }
  }
}

constexpr int ATT_KS = 64 * 72;
template <int DV>
DI void attn_job(const u16* __restrict__ qk, size_t qrow, int qcol, int kcol, size_t kbase, const u16* __restrict__ vt,
                 int s0, int n0, int s1, int n1, bool na, int na_rlo, int na_r0w, int na_rq, int na_qc,
                 const float* rpb_lds, char* smem, f32x16 (&O)[DV / 32], float& l_out) {
  u16* Ks = (u16*)smem;
  u16* Vs = Ks + 2 * ATT_KS;
  constexpr int NV = DV / 32;
  const int tid = threadIdx.x, lane = tid & 63, r = lane & 31, h = lane >> 5;
  bf16x8 qf[4];
#pragma unroll
  for (int s = 0; s < 4; ++s) qf[s] = *(const bf16x8*)(qk + (qrow + r) * 2048 + qcol + 16 * s + 8 * h);
#pragma unroll
  for (int d = 0; d < NV; ++d) O[d] = zero16();
  float m = -1e30f, l = 0.f;
  const float sc = 0.125f * LOG2E;
  const int nt = n0 + n1;
  const int lrow = tid >> 3, lcc = (tid & 7) * 8;
  u32x4 rk[2], rv[NV];
  auto gload = [&](int t) {
    const int tok0 = t < n0 ? s0 + 64 * t : s1 + 64 * (t - n0);
#pragma unroll
    for (int i = 0; i < 2; ++i) rk[i] = *(const u32x4*)(qk + (kbase + tok0 + lrow + 32 * i) * 2048 + kcol + lcc);
#pragma unroll
    for (int i = 0; i < NV; ++i) rv[i] = *(const u32x4*)(vt + (size_t)(lrow + 32 * i) * UB + tok0 + lcc);
  };
  auto sstore = [&](int buf) {
#pragma unroll
    for (int i = 0; i < 2; ++i) *(u32x4*)(Ks + buf * ATT_KS + (lrow + 32 * i) * 72 + lcc) = rk[i];
#pragma unroll
    for (int i = 0; i < NV; ++i) *(u32x4*)(Vs + buf * DV * 72 + (lrow + 32 * i) * 72 + lcc) = rv[i];
  };
  gload(0);
  sstore(0);
  __syncthreads();
  for (int t = 0; t < nt; ++t) {
    const int buf = t & 1;
    if (t + 1 < nt) gload(t + 1);
    bool active = true;
    int kr = 0;
    if (na && t >= n0) {
      kr = na_rlo + (t - n0);
      active = (kr >= na_r0w) && (kr < na_r0w + 8);
    }
    if (active) {
      const u16* kb = Ks + buf * ATT_KS;
      const u16* vb = Vs + buf * DV * 72;
      f32x16 S0 = zero16(), S1 = zero16();
#pragma unroll
      for (int s = 0; s < 4; ++s) {
        bf16x8 a0 = *(const bf16x8*)(kb + r * 72 + 16 * s + 8 * h);
        bf16x8 a1 = *(const bf16x8*)(kb + (32 + r) * 72 + 16 * s + 8 * h);
        S0 = MFMA32(a0, qf[s], S0);
        S1 = MFMA32(a1, qf[s], S1);
      }
      float tv[32];
#pragma unroll
      for (int i = 0; i < 16; ++i) {
        tv[i] = S0[i] * sc;
        tv[16 + i] = S1[i] * sc;
      }
      if (na && t >= n0) {
        const int cs = min(max(na_qc - 8, 0), 48);
        const float* brow = rpb_lds + (kr - na_rq + 7) * 31;
#pragma unroll
        for (int i = 0; i < 32; ++i) {
          int kc = (i >> 4) * 32 + crow(i & 15, h);
          bool ok = (kc >= cs) && (kc < cs + 16);
          int ci = min(max(kc - na_qc + 15, 0), 30);
          float bias = brow[ci];
          tv[i] = ok ? tv[i] + bias * LOG2E : -1e30f;
        }
      }
      float tm = tv[0];
#pragma unroll
      for (int i = 1; i < 32; ++i) tm = fmaxf(tm, tv[i]);
      {
        auto rr = __builtin_amdgcn_permlane32_swap(__float_as_uint(tm), __float_as_uint(tm), false, false);
        tm = fmaxf(__uint_as_float(rr[0]), __uint_as_float(rr[1]));
      }
      float mn = m;
      if (!__all(tm - m <= 8.f)) {
        mn = fmaxf(m, tm);
        const float alpha = __builtin_amdgcn_exp2f(m - mn);
        m = mn;
        l *= alpha;
#pragma unroll
        for (int d = 0; d < NV; ++d)
#pragma unroll
          for (int i = 0; i < 16; ++i) O[d][i] *= alpha;
      }
      float ps = 0.f;
#pragma unroll
      for (int i = 0; i < 32; ++i) {
        tv[i] = __builtin_amdgcn_exp2f(tv[i] - mn);
        ps += tv[i];
      }
      l += ps;
      bf16x8 pf[4];
#pragma unroll
      for (int s = 0; s < 4; ++s) {
        u32x4 u;
        u.x = pack2(tv[8 * s], tv[8 * s + 1]);
        u.y = pack2(tv[8 * s + 2], tv[8 * s + 3]);
        u.z = pack2(tv[8 * s + 4], tv[8 * s + 5]);
        u.w = pack2(tv[8 * s + 6], tv[8 * s + 7]);
        pf[s] = __builtin_bit_cast(bf16x8, u);
      }
#pragma unroll
      for (int d = 0; d < NV; ++d) {
        const u16* vp = vb + (32 * d + r) * 72 + 4 * h;
#pragma unroll
        for (int s = 0; s < 4; ++s) {
          u32x2 lo = *(const u32x2*)(vp + 16 * s);
          u32x2 hi = *(const u32x2*)(vp + 16 * s + 8);
          u32x4 u;
          u.x = lo.x; u.y = lo.y; u.z = hi.x; u.w = hi.y;
          O[d] = MFMA32(__builtin_bit_cast(bf16x8, u), pf[s], O[d]);
        }
      }
    }
    if (t + 1 < nt) sstore(buf ^ 1);
    __syncthreads();
  }
  l_out = l + __shfl_xor(l, 32);
}

DI void phase_attn(const Params& p, char* smem) {
  const u16* QK = (const u16*)(p.ws + OFF_BIG);
  const u16* VT = (const u16*)(p.ws + OFF_VT);
  u16* Y = (u16*)(p.ws + OFF_H);
  const float lam = ((const float*)(p.ws + OFF_MISC))[0];
  float* rpb_lds = (float*)(smem + 2 * (ATT_KS + 128 * 72) * 2);
  const int tid = threadIdx.x, lane = tid & 63, wave = tid >> 6, r = lane & 31, h = lane >> 5;
  const int N_A = 1024, N_B = 2048, N_D = 32, N_C = 64;
  for (int item = blockIdx.x; item < N_A + N_B + N_D + N_C; item += gridDim.x) {
    const bool is_diff = item < N_A || (item >= N_A + N_B && item < N_A + N_B + N_D);
    if (is_diff) {
      int b, hd, uu, ntile;
      if (item < N_A) {
        int grp = item >> 6, qt = item & 63;
        if ((gridDim.x & 7) == 0 && gridDim.x >= 512) {
          int lin = (item / (int)gridDim.x) * (gridDim.x >> 3) + (blockIdx.x >> 3);
          grp = (blockIdx.x & 7) + 8 * (lin >> 6);
          qt = lin & 63;
        }
        b = grp >> 2; hd = grp & 3;
        uu = CTX + qt * 128 + wave * 32;
        ntile = UB / 64;
      } else {
        int it = item - N_A - N_B;
        b = it >> 3; hd = (it >> 1) & 3;
        uu = (it & 1) * 128 + wave * 32;
        ntile = CTX / 64;
      }
      const u16* vt = VT + ((size_t)b * 1024 + 512 + hd * 128) * UB;
      f32x16 O[4];
      float l;
      u16* yrow = Y + ((size_t)b * UB + uu + r) * 1024 + 512 + hd * 128;
      attn_job<128>(QK, (size_t)b * UB + uu, 1024 + hd * 128, 1536 + hd * 128, (size_t)b * UB, vt, 0, ntile, 0, 0, false, 0, 0, 0,
                    0, nullptr, smem, O, l);
      {
        float inv = 1.f / l;
#pragma unroll
        for (int d = 0; d < 4; ++d)
#pragma unroll
          for (int g4 = 0; g4 < 4; ++g4) {
            u32x2 o;
            o.x = pack2(O[d][4 * g4] * inv, O[d][4 * g4 + 1] * inv);
            o.y = pack2(O[d][4 * g4 + 2] * inv, O[d][4 * g4 + 3] * inv);
            *(u32x2*)(yrow + 32 * d + 8 * g4 + 4 * h) = o;
          }
      }
      attn_job<128>(QK, (size_t)b * UB + uu, 1024 + hd * 128 + 64, 1536 + hd * 128 + 64, (size_t)b * UB, vt, 0, ntile, 0, 0, false,
                    0, 0, 0, 0, nullptr, smem, O, l);
      float f = lam / l;
      float ss = 0.f;
#pragma unroll
      for (int d = 0; d < 4; ++d)
#pragma unroll
        for (int g4 = 0; g4 < 4; ++g4) {
          u32x2 o1 = *(const u32x2*)(yrow + 32 * d + 8 * g4 + 4 * h);
          float a0 = bflo(o1.x) - O[d][4 * g4] * f, a1 = bfhi(o1.x) - O[d][4 * g4 + 1] * f;
          float a2 = bflo(o1.y) - O[d][4 * g4 + 2] * f, a3 = bfhi(o1.y) - O[d][4 * g4 + 3] * f;
          O[d][4 * g4] = a0; O[d][4 * g4 + 1] = a1; O[d][4 * g4 + 2] = a2; O[d][4 * g4 + 3] = a3;
          ss += a0 * a0 + a1 * a1 + a2 * a2 + a3 * a3;
        }
      ss += __shfl_xor(ss, 32);
      float rs = rsqrtf(ss * (1.f / 128.f) + EPS) * 0.8f;
#pragma unroll
      for (int d = 0; d < 4; ++d)
#pragma unroll
        for (int g4 = 0; g4 < 4; ++g4) {
          int dd = 32 * d + 8 * g4 + 4 * h;
          float4 sw = *(const float4*)(p.att_subln + dd);
          u32x2 o;
          o.x = pack2(O[d][4 * g4] * rs * sw.x, O[d][4 * g4 + 1] * rs * sw.y);
          o.y = pack2(O[d][4 * g4 + 2] * rs * sw.z, O[d][4 * g4 + 3] * rs * sw.w);
          *(u32x2*)(yrow + dd) = o;
        }
    } else {
      int b, hh, uu, s1 = 0, n1 = 0, rlo = 0, r0w = 0, rq = 0, qc = 0;
      bool na = false;
      if (item < N_A + N_B) {
        int it = item - N_A;
        b = it >> 9; hh = (it >> 6) & 7;
        int rp = it & 63;
        rq = rp * 2 + (wave >> 1);
        int half = wave & 1;
        uu = CTX + rq * 64 + half * 32;
        rlo = min(max(rp * 2 - 4, 0), 120);
        int rhi = min(max(rp * 2 + 1 - 4, 0), 120);
        r0w = min(max(rq - 4, 0), 120);
        s1 = CTX + rlo * 64;
        n1 = rhi - rlo + 8;
        qc = half * 32 + r;
        na = true;
        __syncthreads();
        for (int i = tid; i < 15 * 31; i += 256) rpb_lds[i] = p.att_rpb[hh * 15 * 31 + i];
      } else {
        int it = item - N_A - N_B - N_D;
        b = it >> 4; hh = (it >> 1) & 7;
        uu = (it & 1) * 128 + wave * 32;
      }
      f32x16 O[2];
      float l;
      attn_job<64>(QK, (size_t)b * UB + uu, hh * 64, 512 + hh * 64, (size_t)b * UB, VT + ((size_t)b * 1024 + hh * 64) * UB, 0,
                   CTX / 64, s1, n1, na, rlo, r0w, rq, qc, rpb_lds, smem, O, l);
      float inv = 1.f / l;
      u16* yrow = Y + ((size_t)b * UB + uu + r) * 1024 + hh * 64;
#pragma unroll
      for (int d = 0; d < 2; ++d)
#pragma unroll
        for (int g4 = 0; g4 < 4; ++g4) {
          int dd = 32 * d + 8 * g4 + 4 * h;
          u32x2 o;
          o.x = pack2(O[d][4 * g4] * inv, O[d][4 * g4 + 1] * inv);
          o.y = pack2(O[d][4 * g4 + 2] * inv, O[d][4 * g4 + 3] * inv);
          *(u32x2*)(yrow + dd) = o;
        }
    }
  }
}

constexpr int CP = 136;
constexpr int TP = 40;
DI bf16x8 ld_perm(const u16* rowp, int off) {
  u32x2 lo = *(const u32x2*)(rowp + off);
  u32x2 hi = *(const u32x2*)(rowp + off + 8);
  u32x4 u = {lo.x, lo.y, hi.x, hi.y};
  return __builtin_bit_cast(bf16x8, u);
}
DI bf16x8 pack8(const f32x16& x, int s2) {
  u32x4 u;
  u.x = pack2(x[8 * s2], x[8 * s2 + 1]);
  u.y = pack2(x[8 * s2 + 2], x[8 * s2 + 3]);
  u.z = pack2(x[8 * s2 + 4], x[8 * s2 + 5]);
  u.w = pack2(x[8 * s2 + 6], x[8 * s2 + 7]);
  return __builtin_bit_cast(bf16x8, u);
}

DI float ld_dev(const float* p) { return __hip_atomic_load(p, __ATOMIC_RELAXED, __HIP_MEMORY_SCOPE_AGENT); }
DI void st_dev(float* p, float v) { __hip_atomic_store(p, v, __ATOMIC_RELAXED, __HIP_MEMORY_SCOPE_AGENT); }
DI float4 ld_dev4(const float* p) { return make_float4(ld_dev(p), ld_dev(p + 1), ld_dev(p + 2), ld_dev(p + 3)); }
DI void st_dev4(float* p, float4 v) { st_dev(p, v.x); st_dev(p + 1, v.y); st_dev(p + 2, v.z); st_dev(p + 3, v.w); }
DI bf16x8 ld_perm_dev(const u16* rowp, int off) {
  const unsigned* q = (const unsigned*)(rowp + off);
  u32x4 u;
  u.x = __hip_atomic_load(q, __ATOMIC_RELAXED, __HIP_MEMORY_SCOPE_AGENT);
  u.y = __hip_atomic_load(q + 1, __ATOMIC_RELAXED, __HIP_MEMORY_SCOPE_AGENT);
  u.z = __hip_atomic_load(q + 4, __ATOMIC_RELAXED, __HIP_MEMORY_SCOPE_AGENT);
  u.w = __hip_atomic_load(q + 5, __ATOMIC_RELAXED, __HIP_MEMORY_SCOPE_AGENT);
  return __builtin_bit_cast(bf16x8, u);
}
DI void scan_gdn_seg(const Params& p, char* smem, int chain, int seg, int mode) {
  const u16* PROJ = (const u16*)(p.ws + OFF_BIG);
  const float* DAB = (const float*)(p.ws + OFF_DAB);
  const int dir = chain & 1, hd = (chain >> 1) & 3, b = chain >> 3;
  u16* OUT = (u16*)(p.ws + (dir ? OFF_OB : OFF_H));
  u16* Qb = (u16*)smem;
  u16* Kb = Qb + 32 * CP;
  u16* KTT = Kb + 32 * CP;
  u16* VT = KTT + 128 * TP;
  float* VB = (float*)(VT + 128 * TP);
  float* AM = VB + 32 * 128;
  u16* AQK = (u16*)(AM + 32 * 36);
  float* SC = (float*)(AQK + 32 * TP);
  float* cwl = SC + 128;
  int tid0 = threadIdx.x;
  asm volatile("" : "+v"(tid0));
  int tid = tid0, lane = tid & 63, wave = tid >> 6, r = lane & 31, h = lane >> 5;
  int ti = tid >> 3, sj = tid & 7;
  __syncthreads();
  for (int i = tid; i < 1152; i += 256) {
    int tap = i / 384, c = i - tap * 384;
    cwl[i] = p.rec_conv_w[tap * 1536 + (c >> 7) * 512 + hd * 128 + (c & 127)];
  }
  f32x16 S[4];
#pragma unroll
  for (int d = 0; d < 4; ++d) S[d] = zero16();
  float* GS = (float*)(p.ws + OFF_GS);
  u16* GP = (u16*)(p.ws + OFF_GP);
  if (mode == 1) {
#pragma unroll
    for (int d = 0; d < 4; ++d)
#pragma unroll
      for (int i = 0; i < 16; ++i) S[d][i] = (32 * d + crow(i, h) == 32 * wave + r) ? 1.f : 0.f;
  } else if (mode == 2 && seg > 0) {
    const float* src = GS + (size_t)(chain * NHO_G + seg - 1) * 16384 + (32 * wave + r) * 128 + 4 * h;
#pragma unroll
    for (int d = 0; d < 4; ++d)
#pragma unroll
      for (int g4 = 0; g4 < 4; ++g4) {
        const float4 v = ld_dev4(src + 32 * d + 8 * g4);
        S[d][4 * g4] = v.x; S[d][4 * g4 + 1] = v.y; S[d][4 * g4 + 2] = v.z; S[d][4 * g4 + 3] = v.w;
      }
  }
  const float vb_scale = (mode == 1) ? 0.f : 1.f;
  unsigned pf0 = 0u, pf1 = 0u, pfsink = 0u;
  const bool with_out = mode == 2;
  __syncthreads();
  for (int blk = seg * SEGC_G; blk < seg * SEGC_G + SEGC_G; ++blk) {
    tid = tid0;
    asm volatile("" : "+v"(tid));
    lane = tid & 63; wave = __builtin_amdgcn_readfirstlane(tid >> 6); r = lane & 31; h = lane >> 5; ti = tid >> 3; sj = tid & 7;
    const bool isctx = blk < 8;
    const int seg_base = isctx ? 0 : CTX, seg_len = isctx ? CTX : SEQ;
    const int bi = isctx ? blk : blk - 8;
    {
      const int sidx = bi * 32 + ti;
      const int pos = dir ? seg_len - 1 - sidx : sidx;
      const size_t row = (size_t)b * UB + seg_base + pos;
      const u16* pr = PROJ + row * NPROJ;
      const float mp = pos > 0 ? 1.f : 0.f, mn = pos < seg_len - 1 ? 1.f : 0.f;
      const float g = DAB[row * 16 + dir * 4 + hd], beta = DAB[row * 16 + 8 + dir * 4 + hd];
      const float betav = beta * vb_scale;
      if (sj == 0) SC[ti * 4] = g;
#pragma unroll
      for (int pp = 0; pp < 3; ++pp) {
        const int part = (pp + 2) % 3;
        if (part == 0 && !with_out) continue;
        if (part == 2 && mode == 1) {
#pragma unroll
          for (int k = 0; k < 4; ++k) *(float4*)(VB + ti * 128 + sj * 16 + 4 * k) = make_float4(0.f, 0.f, 0.f, 0.f);
          continue;
        }
        float val[16];
        const u16* pc = pr + 2560 + part * 512 + hd * 128 + sj * 16;
        const float* cw = cwl + part * 128 + sj * 16;
#pragma unroll
        for (int half = 0; half < 2; ++half) {
          u32x4 x0 = *(const u32x4*)(pc - NPROJ + half * 8);
          u32x4 x1 = *(const u32x4*)(pc + half * 8);
          u32x4 x2 = *(const u32x4*)(pc + NPROJ + half * 8);
          unsigned a0[4] = {x0.x, x0.y, x0.z, x0.w}, a1[4] = {x1.x, x1.y, x1.z, x1.w}, a2[4] = {x2.x, x2.y, x2.z, x2.w};
#pragma unroll
          for (int k = 0; k < 4; ++k) {
            int c0 = half * 8 + 2 * k;
            float y0 = cw[c0] * mp * bflo(a0[k]) + cw[384 + c0] * bflo(a1[k]) + cw[768 + c0] * mn * bflo(a2[k]);
            float y1 = cw[c0 + 1] * mp * bfhi(a0[k]) + cw[384 + c0 + 1] * bfhi(a1[k]) + cw[768 + c0 + 1] * mn * bfhi(a2[k]);
            val[c0] = siluf_(y0);
            val[c0 + 1] = siluf_(y1);
          }
          __builtin_amdgcn_sched_barrier(0);
        }
        if (part == 2) {
#pragma unroll
          for (int k = 0; k < 4; ++k)
            *(float4*)(VB + ti * 128 + sj * 16 + 4 * k) =
                make_float4(betav * val[4 * k], betav * val[4 * k + 1], betav * val[4 * k + 2], betav * val[4 * k + 3]);
        } else {
          float ss = 0.f;
#pragma unroll
          for (int k = 0; k < 16; ++k) ss += val[k] * val[k];
          ss = dpp_sum8(ss);
          const float rn = rsqrtf(ss + EPS) * (part == 0 ? 0.08838834764831845f : 1.f);
          u16* dstp = (part == 0 ? Qb : Kb) + ti * CP + sj * 16;
#pragma unroll
          for (int hh = 0; hh < 2; ++hh) {
            u32x4 o;
            o.x = pack2(val[8 * hh] * rn, val[8 * hh + 1] * rn); o.y = pack2(val[8 * hh + 2] * rn, val[8 * hh + 3] * rn);
            o.z = pack2(val[8 * hh + 4] * rn, val[8 * hh + 5] * rn); o.w = pack2(val[8 * hh + 6] * rn, val[8 * hh + 7] * rn);
            *(u32x4*)(dstp + 8 * hh) = o;
          }
        }
        __builtin_amdgcn_sched_barrier(0);
      }
      __syncthreads();
      float G = 0.f, Gl = 0.f;
      for (int t = 0; t < 32; ++t) {
        float gt = SC[t * 4];
        Gl += gt;
        G += (t <= ti) ? gt : 0.f;
      }
      const float eG = __expf(G), eT = __expf(Gl - G);
      __syncthreads();
      if (sj == 0) *(float4*)(SC + ti * 4) = make_float4(G, beta, eG, eT);
      if (tid == 0) AM[35] = __expf(Gl);
      {
        const u32x4 k0 = *(const u32x4*)(Kb + ti * CP + sj * 16), k1 = *(const u32x4*)(Kb + ti * CP + sj * 16 + 8);
        const unsigned kk[8] = {k0.x, k0.y, k0.z, k0.w, k1.x, k1.y, k1.z, k1.w};
#pragma unroll
        for (int k = 0; k < 8; ++k) {
          KTT[(sj * 16 + 2 * k) * TP + ti] = f2bf(bflo(kk[k]) * eT);
          KTT[(sj * 16 + 2 * k + 1) * TP + ti] = f2bf(bfhi(kk[k]) * eT);
        }
      }
    }
    __syncthreads();
    f32x16 KS = zero16();
#pragma unroll
    for (int d = 0; d < 4; ++d)
#pragma unroll
      for (int s2 = 0; s2 < 2; ++s2) {
        const bf16x8 sp = pack8(S[d], s2);
        KS = MFMA32(ld_perm(Kb + r * CP, 32 * d + 16 * s2 + 4 * h), sp, KS);
        __builtin_amdgcn_sched_barrier(0);
      }
    if (wave == 0 || (wave == 1 && with_out)) {
      f32x16 X = zero16();
      const u16* ap = (wave == 0 ? Kb : Qb) + r * CP + 8 * h;
      const u16* bp = Kb + r * CP + 8 * h;
#pragma unroll
      for (int ks = 0; ks < 8; ++ks) X = MFMA32(*(const bf16x8*)(ap + 16 * ks), *(const bf16x8*)(bp + 16 * ks), X);
      const float Gs = SC[r * 4];
#pragma unroll
      for (int i = 0; i < 16; ++i) {
        const int c = crow(i, h);
        const float4 sc = *(const float4*)(SC + c * 4);
        const float gam = __expf(fminf(sc.x - Gs, 0.f));
        if (wave == 0) AM[c * 36 + r] = (r < c) ? sc.y * X[i] * gam : 0.f;
        else AQK[c * TP + r] = f2bf((r <= c) ? X[i] * gam : 0.f);
      }
    }
#pragma unroll
    for (int i = 0; i < 16; ++i) {
      const int t = crow(i, h);
      const float4 sc = *(const float4*)(SC + t * 4);
      float* vb = VB + t * 128 + 32 * wave + r;
      *vb = *vb - sc.y * sc.z * KS[i];
    }
    __syncthreads();
    if (tid >= 128) {
      pfsink ^= pf0 ^ pf1;
      pf0 = 0u; pf1 = 0u;
      const int nb = blk + 1;
      if (nb < seg * SEGC_G + SEGC_G) {
        const bool nctx = nb < 8;
        const int nbase = nctx ? 0 : CTX, nlen = nctx ? CTX : SEQ, nbi = nctx ? nb : nb - 8;
        const int rlo = (dir ? nlen - 32 - nbi * 32 : nbi * 32) - 1;
        const u16* pbase = PROJ + ((size_t)b * UB + nbase + rlo) * NPROJ + 2560 + hd * 128;
        const int l0 = tid - 128, l1 = tid;
        pf0 = *(const unsigned*)(pbase + (size_t)(l0 / 6) * NPROJ + ((l0 % 6) >> 1) * 512 + ((l0 % 6) & 1) * 64);
        if (l1 < 204) pf1 = *(const unsigned*)(pbase + (size_t)(l1 / 6) * NPROJ + ((l1 % 6) >> 1) * 512 + ((l1 % 6) & 1) * 64);
        else if (l1 < 220)
          pf1 = __float_as_uint(DAB[((size_t)b * UB + nbase + rlo + 1) * 16 + (l1 - 204) * 32]);
      }
    }
    if (tid < 128) {
      float x[16];
#pragma unroll
      for (int c = 0; c < 16; ++c) {
        float acc = VB[c * 128 + tid];
#pragma unroll
        for (int s4 = 0; s4 < (c + 3) / 4; ++s4) {
          const float4 a4 = *(const float4*)(AM + c * 36 + 4 * s4);
          if (4 * s4 < c) acc -= a4.x * x[4 * s4];
          if (4 * s4 + 1 < c) acc -= a4.y * x[4 * s4 + 1];
          if (4 * s4 + 2 < c) acc -= a4.z * x[4 * s4 + 2];
          if (4 * s4 + 3 < c) acc -= a4.w * x[4 * s4 + 3];
        }
        x[c] = acc;
        __builtin_amdgcn_sched_barrier(0);
      }
#pragma unroll
      for (int q4 = 0; q4 < 2; ++q4) {
        u32x4 u;
        u.x = pack2(x[8 * q4], x[8 * q4 + 1]); u.y = pack2(x[8 * q4 + 2], x[8 * q4 + 3]);
        u.z = pack2(x[8 * q4 + 4], x[8 * q4 + 5]); u.w = pack2(x[8 * q4 + 6], x[8 * q4 + 7]);
        *(u32x4*)(VT + tid * TP + 8 * q4) = u;
      }
#pragma unroll
      for (int c = 16; c < 32; ++c) {
        float acc = VB[c * 128 + tid];
#pragma unroll
        for (int s4 = 0; s4 < 4; ++s4) {
          const float4 a4 = *(const float4*)(AM + c * 36 + 4 * s4);
          acc -= a4.x * x[4 * s4] + a4.y * x[4 * s4 + 1] + a4.z * x[4 * s4 + 2] + a4.w * x[4 * s4 + 3];
        }
        VB[c * 128 + tid] = acc;
        __builtin_amdgcn_sched_barrier(0);
      }
#pragma unroll
      for (int c = 16; c < 32; ++c) {
        float acc = VB[c * 128 + tid];
#pragma unroll
        for (int s4 = 4; s4 < (c + 3) / 4; ++s4) {
          const float4 a4 = *(const float4*)(AM + c * 36 + 4 * s4);
          if (4 * s4 < c) acc -= a4.x * x[4 * s4 - 16];
          if (4 * s4 + 1 < c) acc -= a4.y * x[4 * s4 + 1 - 16];
          if (4 * s4 + 2 < c) acc -= a4.z * x[4 * s4 + 2 - 16];
          if (4 * s4 + 3 < c) acc -= a4.w * x[4 * s4 + 3 - 16];
        }
        x[c - 16] = acc;
        __builtin_amdgcn_sched_barrier(0);
      }
#pragma unroll
      for (int q4 = 0; q4 < 2; ++q4) {
        u32x4 u;
        u.x = pack2(x[8 * q4], x[8 * q4 + 1]); u.y = pack2(x[8 * q4 + 2], x[8 * q4 + 3]);
        u.z = pack2(x[8 * q4 + 4], x[8 * q4 + 5]); u.w = pack2(x[8 * q4 + 6], x[8 * q4 + 7]);
        *(u32x4*)(VT + tid * TP + 16 + 8 * q4) = u;
      }
    }
    __syncthreads();
    {
      const bf16x8 vf0 = *(const bf16x8*)(VT + (32 * wave + r) * TP + 8 * h);
      const bf16x8 vf1 = *(const bf16x8*)(VT + (32 * wave + r) * TP + 16 + 8 * h);
      if (with_out && !isctx) {
        f32x16 QS = zero16();
#pragma unroll
        for (int d = 0; d < 4; ++d)
#pragma unroll
          for (int s2 = 0; s2 < 2; ++s2)
            QS = MFMA32(ld_perm(Qb + r * CP, 32 * d + 16 * s2 + 4 * h), pack8(S[d], s2), QS);
#pragma unroll
        for (int i = 0; i < 16; ++i) QS[i] *= SC[crow(i, h) * 4 + 2];
        QS = MFMA32(*(const bf16x8*)(AQK + r * TP + 8 * h), vf0, QS);
        QS = MFMA32(*(const bf16x8*)(AQK + r * TP + 16 + 8 * h), vf1, QS);
        const int pos0 = dir ? seg_len - 1 - bi * 32 : bi * 32;
        u16* op = OUT + ((size_t)b * UB + seg_base + pos0) * 1024 + 512 + hd * 128 + 32 * wave + r;
        int ostep = dir ? -1024 : 1024;
        asm volatile("" : "+s"(ostep));
#pragma unroll
        for (int i = 0; i < 16; ++i) op[crow(i, h) * ostep] = f2bf(QS[i]);
      }
      const float dec = AM[35];
#pragma unroll
      for (int d = 0; d < 4; ++d) {
#pragma unroll
        for (int i = 0; i < 16; ++i) S[d][i] *= dec;
        S[d] = MFMA32(*(const bf16x8*)(KTT + (32 * d + r) * TP + 8 * h), vf0, S[d]);
        S[d] = MFMA32(*(const bf16x8*)(KTT + (32 * d + r) * TP + 16 + 8 * h), vf1, S[d]);
      }
    }
    __syncthreads();
  }
  if (tid >= 128) ((unsigned*)(p.ws + OFF_BAR))[1 + (tid & 63)] = pfsink ^ pf0 ^ pf1;
  if (mode == 0) {
    float* dst = GS + (size_t)(chain * NHO_G + seg) * 16384 + (32 * wave + r) * 128 + 4 * h;
#pragma unroll
    for (int d = 0; d < 4; ++d)
#pragma unroll
      for (int g4 = 0; g4 < 4; ++g4)
        st_dev4(dst + 32 * d + 8 * g4, make_float4(S[d][4 * g4], S[d][4 * g4 + 1], S[d][4 * g4 + 2], S[d][4 * g4 + 3]));
  } else if (mode == 1) {
    u16* dst = GP + (size_t)(chain * NHO_G + seg) * 16384 + 32 * wave + r;
#pragma unroll
    for (int d = 0; d < 4; ++d)
#pragma unroll
      for (int i = 0; i < 16; ++i) __hip_atomic_store(dst + (32 * d + crow(i, h)) * 128, f2bf(S[d][i]), __ATOMIC_RELAXED, __HIP_MEMORY_SCOPE_AGENT);
  }
}

DI void scan_hgrn_seg(const Params& p, char* smem, int chain, int seg, int mode) {
  const u16* PROJ = (const u16*)(p.ws + OFF_BIG);
  const float* misc = (const float*)(p.ws + OFF_MISC);
  const int dir = chain & 1, hd = (chain >> 1) & 3, b = chain >> 3;
  u16* OUT = (u16*)(p.ws + (dir ? OFF_OB : OFF_H));
  u16* QG = (u16*)smem;
  u16* QP = QG + 32 * CP;
  u16* KT = QP + 32 * CP;
  u16* KTT = KT + 32 * CP;
  u16* VT = KTT + 128 * TP;
  u16* AQK = VT + 128 * TP;
  float* LG = (float*)(AQK + 32 * TP);
  float* GL = LG + 32 * 128;
  float* lbs = GL + 128;
  int tid0 = threadIdx.x;
  asm volatile("" : "+v"(tid0));
  int tid = tid0, lane = tid & 63, wave = tid >> 6, r = lane & 31, h = lane >> 5;
  int ti = tid >> 3, sj = tid & 7;
  __syncthreads();
  if (tid < 128) lbs[tid] = misc[16 + dir * 512 + hd * 128 + tid];
  f32x16 S[4];
#pragma unroll
  for (int d = 0; d < 4; ++d) S[d] = zero16();
  float* HS = (float*)(p.ws + OFF_HS);
  float* HD = (float*)(p.ws + OFF_HD);
  if (mode == 2 && seg > 0) {
    const float* src = HS + (size_t)(chain * NHO_H + seg - 1) * 16384 + (32 * wave + r) * 128 + 4 * h;
#pragma unroll
    for (int d = 0; d < 4; ++d)
#pragma unroll
      for (int g4 = 0; g4 < 4; ++g4) {
        const float4 v = ld_dev4(src + 32 * d + 8 * g4);
        S[d][4 * g4] = v.x; S[d][4 * g4 + 1] = v.y; S[d][4 * g4 + 2] = v.z; S[d][4 * g4 + 3] = v.w;
      }
  }
  const bool with_out = mode == 2;
  float dsum = 0.f;
  __syncthreads();
  for (int blk = seg * SEGC_H; blk < seg * SEGC_H + SEGC_H; ++blk) {
    tid = tid0;
    asm volatile("" : "+v"(tid));
    lane = tid & 63; wave = __builtin_amdgcn_readfirstlane(tid >> 6); r = lane & 31; h = lane >> 5; ti = tid >> 3; sj = tid & 7;
    const bool isctx = blk < 8;
    const int seg_base = isctx ? 0 : CTX, seg_len = isctx ? CTX : SEQ;
    const int bi = isctx ? blk : blk - 8;
    {
      const int sidx = bi * 32 + ti;
      const int pos = dir ? seg_len - 1 - sidx : sidx;
      const size_t row = (size_t)b * UB + seg_base + pos;
      const u16* pr = PROJ + row * NPROJ;
      const u16* pq = pr + hd * 128 + sj * 16;
      const u16* pf = pr + (dir ? 1024 : 512) + hd * 128 + sj * 16;
      const u16* pv = pr + 1536 + hd * 128 + sj * 16;
      u32x4 q0 = *(const u32x4*)pq, q1 = *(const u32x4*)(pq + 8);
      u32x4 f0 = *(const u32x4*)pf, f1 = *(const u32x4*)(pf + 8);
      u32x4 v0 = *(const u32x4*)pv, v1 = *(const u32x4*)(pv + 8);
      unsigned qa[8] = {q0.x, q0.y, q0.z, q0.w, q1.x, q1.y, q1.z, q1.w};
      unsigned fa[8] = {f0.x, f0.y, f0.z, f0.w, f1.x, f1.y, f1.z, f1.w};
      unsigned va[8] = {v0.x, v0.y, v0.z, v0.w, v1.x, v1.y, v1.z, v1.w};
      float qv[16], kv[16];
#pragma unroll
      for (int k = 0; k < 8; ++k) {
        const float l0 = lbs[sj * 16 + 2 * k], l1 = lbs[sj * 16 + 2 * k + 1];
        qv[2 * k] = siluf_(bflo(qa[k])) * 0.08838834764831845f;
        qv[2 * k + 1] = siluf_(bfhi(qa[k])) * 0.08838834764831845f;
        const float fa0 = l0 + (1.f - l0) * sigmoidf_(bflo(fa[k]));
        const float fa1 = l1 + (1.f - l1) * sigmoidf_(bfhi(fa[k]));
        kv[2 * k] = 1.f - fa0;
        kv[2 * k + 1] = 1.f - fa1;
        LG[ti * 128 + sj * 16 + 2 * k] = __logf(fa0);
        LG[ti * 128 + sj * 16 + 2 * k + 1] = __logf(fa1);
        VT[(sj * 16 + 2 * k) * TP + ti] = (u16)(va[k] & 0xffffu);
        VT[(sj * 16 + 2 * k + 1) * TP + ti] = (u16)(va[k] >> 16);
      }
      __syncthreads();
      if (tid < 128) {
        float cv[32];
#pragma unroll
        for (int t = 0; t < 32; ++t) cv[t] = LG[t * 128 + tid];
        float acc = 0.f;
#pragma unroll
        for (int t = 0; t < 32; ++t) {
          acc += cv[t];
          LG[t * 128 + tid] = acc;
        }
        GL[tid] = __expf(acc);
        dsum += acc;
      }
      __syncthreads();
      u32x4 o0[2], o1[2], o2[2];
      unsigned w0[8], w1[8], w2[8];
#pragma unroll
      for (int k = 0; k < 8; ++k) {
        const int d0 = sj * 16 + 2 * k;
        const float G0 = LG[ti * 128 + d0], G1 = LG[ti * 128 + d0 + 1];
        const float L0 = LG[31 * 128 + d0], L1 = LG[31 * 128 + d0 + 1];
        const float kt0 = kv[2 * k] * __expf(L0 - G0), kt1 = kv[2 * k + 1] * __expf(L1 - G1);
        w0[k] = pack2(qv[2 * k] * __expf(G0), qv[2 * k + 1] * __expf(G1));
        w1[k] = pack2(qv[2 * k] * __expf(G0 - L0), qv[2 * k + 1] * __expf(G1 - L1));
        w2[k] = pack2(kt0, kt1);
        KTT[d0 * TP + ti] = (u16)(w2[k] & 0xffffu);
        KTT[(d0 + 1) * TP + ti] = (u16)(w2[k] >> 16);
      }
#pragma unroll
      for (int hh = 0; hh < 2; ++hh) {
        o0[hh] = (u32x4){w0[4 * hh], w0[4 * hh + 1], w0[4 * hh + 2], w0[4 * hh + 3]};
        o1[hh] = (u32x4){w1[4 * hh], w1[4 * hh + 1], w1[4 * hh + 2], w1[4 * hh + 3]};
        o2[hh] = (u32x4){w2[4 * hh], w2[4 * hh + 1], w2[4 * hh + 2], w2[4 * hh + 3]};
        *(u32x4*)(QG + ti * CP + sj * 16 + 8 * hh) = o0[hh];
        *(u32x4*)(QP + ti * CP + sj * 16 + 8 * hh) = o1[hh];
        *(u32x4*)(KT + ti * CP + sj * 16 + 8 * hh) = o2[hh];
      }
    }
    __syncthreads();
    f32x16 QS = zero16();
    if (with_out && !isctx) {
#pragma unroll
      for (int d = 0; d < 4; ++d)
#pragma unroll
        for (int s2 = 0; s2 < 2; ++s2)
          QS = MFMA32(ld_perm(QG + r * CP, 32 * d + 16 * s2 + 4 * h), pack8(S[d], s2), QS);
      if (wave == 0) {
        f32x16 X = zero16();
#pragma unroll
        for (int ks = 0; ks < 8; ++ks)
          X = MFMA32(*(const bf16x8*)(QP + r * CP + 16 * ks + 8 * h), *(const bf16x8*)(KT + r * CP + 16 * ks + 8 * h), X);
#pragma unroll
        for (int i = 0; i < 16; ++i) {
          const int c = crow(i, h);
          AQK[c * TP + r] = f2bf((r <= c) ? X[i] : 0.f);
        }
      }
    }
    __syncthreads();
    {
      const bf16x8 vf0 = *(const bf16x8*)(VT + (32 * wave + r) * TP + 8 * h);
      const bf16x8 vf1 = *(const bf16x8*)(VT + (32 * wave + r) * TP + 16 + 8 * h);
      if (with_out && !isctx) {
        QS = MFMA32(*(const bf16x8*)(AQK + r * TP + 8 * h), vf0, QS);
        QS = MFMA32(*(const bf16x8*)(AQK + r * TP + 16 + 8 * h), vf1, QS);
        const int pos0 = dir ? seg_len - 1 - bi * 32 : bi * 32;
        u16* op = OUT + ((size_t)b * UB + seg_base + pos0) * 1024 + hd * 128 + 32 * wave + r;
        int ostep = dir ? -1024 : 1024;
        asm volatile("" : "+s"(ostep));
#pragma unroll
        for (int i = 0; i < 16; ++i) op[crow(i, h) * ostep] = f2bf(QS[i]);
      }
#pragma unroll
      for (int d = 0; d < 4; ++d) {
#pragma unroll
        for (int i = 0; i < 16; ++i) S[d][i] *= GL[32 * d + crow(i, h)];
        S[d] = MFMA32(*(const bf16x8*)(KTT + (32 * d + r) * TP + 8 * h), vf0, S[d]);
        S[d] = MFMA32(*(const bf16x8*)(KTT + (32 * d + r) * TP + 16 + 8 * h), vf1, S[d]);
      }
    }
    __syncthreads();
  }
  if (mode == 0) {
    float* dst = HS + (size_t)(chain * NHO_H + seg) * 16384 + (32 * wave + r) * 128 + 4 * h;
#pragma unroll
    for (int d = 0; d < 4; ++d)
#pragma unroll
      for (int g4 = 0; g4 < 4; ++g4)
        st_dev4(dst + 32 * d + 8 * g4, make_float4(S[d][4 * g4], S[d][4 * g4 + 1], S[d][4 * g4 + 2], S[d][4 * g4 + 3]));
    if (tid < 128) st_dev(HD + (chain * NHO_H + seg) * 128 + tid, __expf(dsum));
  }
}

DI void combine_gdn(const Params& p, int chain) {
  float* GS = (float*)(p.ws + OFF_GS);
  const u16* GP = (const u16*)(p.ws + OFF_GP);
  const int lane = threadIdx.x & 63, wave = threadIdx.x >> 6, r = lane & 31, h = lane >> 5;
  f32x16 S[4], acc[4];
  {
    const float* src = GS + (size_t)(chain * NHO_G) * 16384 + (32 * wave + r) * 128 + 4 * h;
#pragma unroll
    for (int d = 0; d < 4; ++d)
#pragma unroll
      for (int g4 = 0; g4 < 4; ++g4) {
        const float4 v = ld_dev4(src + 32 * d + 8 * g4);
        S[d][4 * g4] = v.x; S[d][4 * g4 + 1] = v.y; S[d][4 * g4 + 2] = v.z; S[d][4 * g4 + 3] = v.w;
      }
  }
#pragma unroll 1
  for (int j = 1; j < NHO_G; ++j) {
    float* loc = GS + (size_t)(chain * NHO_G + j) * 16384 + (32 * wave + r) * 128 + 4 * h;
    const u16* P = GP + (size_t)(chain * NHO_G + j) * 16384;
#pragma unroll
    for (int d = 0; d < 4; ++d)
#pragma unroll
      for (int g4 = 0; g4 < 4; ++g4) {
        const float4 v = ld_dev4(loc + 32 * d + 8 * g4);
        acc[d][4 * g4] = v.x; acc[d][4 * g4 + 1] = v.y; acc[d][4 * g4 + 2] = v.z; acc[d][4 * g4 + 3] = v.w;
      }
#pragma unroll
    for (int d2 = 0; d2 < 4; ++d2)
#pragma unroll
      for (int s2 = 0; s2 < 2; ++s2) {
        const bf16x8 sp = pack8(S[d2], s2);
#pragma unroll
        for (int d = 0; d < 4; ++d) acc[d] = MFMA32(ld_perm_dev(P + (32 * d + r) * 128, 32 * d2 + 16 * s2 + 4 * h), sp, acc[d]);
        __builtin_amdgcn_sched_barrier(0);
      }
#pragma unroll
    for (int d = 0; d < 4; ++d) {
      S[d] = acc[d];
#pragma unroll
      for (int g4 = 0; g4 < 4; ++g4)
        st_dev4(loc + 32 * d + 8 * g4, make_float4(S[d][4 * g4], S[d][4 * g4 + 1], S[d][4 * g4 + 2], S[d][4 * g4 + 3]));
    }
  }
}
DI void combine_hgrn(const Params& p, int chain) {
  float* HS = (float*)(p.ws + OFF_HS);
  const float* HD = (const float*)(p.ws + OFF_HD);
  const int lane = threadIdx.x & 63, wave = threadIdx.x >> 6, r = lane & 31, h = lane >> 5;
  float4 S[16];
  {
    const float* src = HS + (size_t)(chain * NHO_H) * 16384 + (32 * wave + r) * 128 + 4 * h;
#pragma unroll
    for (int q = 0; q < 16; ++q) S[q] = ld_dev4(src + 8 * q);
  }
#pragma unroll 1
  for (int j = 1; j < NHO_H; ++j) {
    float* loc = HS + (size_t)(chain * NHO_H + j) * 16384 + (32 * wave + r) * 128 + 4 * h;
    const float* D = HD + (chain * NHO_H + j) * 128 + 4 * h;
#pragma unroll
    for (int q = 0; q < 16; ++q) {
      const float4 l = ld_dev4(loc + 8 * q), dd = ld_dev4(D + 8 * q);
      S[q] = make_float4(dd.x * S[q].x + l.x, dd.y * S[q].y + l.y, dd.z * S[q].z + l.z, dd.w * S[q].w + l.w);
      st_dev4(loc + 8 * q, S[q]);
      if ((q & 3) == 3) __builtin_amdgcn_sched_barrier(0);
    }
  }
}

DI void phase_scan(const Params& p, char* smem, const XcdBarrier& xb) {
  for (int item = blockIdx.x; item < 32 * NHO_G * 2 + 32 * NHO_H; item += gridDim.x) {
    if (item < 32 * NHO_G * 2) {
      const int rest = item >> 5;
      if (rest != 1)
        scan_gdn_seg(p, smem, item & 31, rest >> 1, rest & 1);
    } else {
      const int k = item - 32 * NHO_G * 2;
      scan_hgrn_seg(p, smem, k & 31, k >> 5, 0);
    }
  }
  xcd_barrier(xb);
  for (int item = blockIdx.x; item < 64; item += gridDim.x) {
    if (item < 32) combine_gdn(p, item);
    else combine_hgrn(p, item - 32);
  }
  xcd_barrier(xb);
  for (int item = blockIdx.x; item < 32 * NSEG_H + 32 * NSEG_G; item += gridDim.x) {
    if (item < 32 * NSEG_H) scan_hgrn_seg(p, smem, item & 31, item >> 5, 2);
    else scan_gdn_seg(p, smem, item & 31, (item - 32 * NSEG_H) >> 5, 2);
  }
}

DI void phase_merge(const Params& p) {
  const u16* PROJ = (const u16*)(p.ws + OFF_BIG);
  u16* H = (u16*)(p.ws + OFF_H);
  const u16* OB = (const u16*)(p.ws + OFF_OB);
  const int lane = threadIdx.x & 63, wave = threadIdx.x >> 6;
  for (int item = blockIdx.x; item < NB * SEQ / 4; item += gridDim.x) {
    int tkn = item * 4 + wave;
    int b = tkn / SEQ, t = tkn - b * SEQ;
    size_t row = (size_t)b * UB + CTX + t;
    int c0 = lane * 16;
    int kind = c0 >> 9;
    const u16* gp = PROJ + row * NPROJ + (kind ? 4096 + (c0 - 512) : 2048 + c0);
    const float* w = (kind ? p.rec_d_norm : p.rec_c_norm) + (c0 & 127);
    u16* hp = H + row * 1024 + c0;
    const u16* bp = OB + row * 1024 + c0;
    float o[16], gt[16];
    float ss = 0.f;
#pragma unroll
    for (int half = 0; half < 2; ++half) {
      uint4 a = *(const uint4*)(hp + half * 8), bq = *(const uint4*)(bp + half * 8), g = *(const uint4*)(gp + half * 8);
      unsigned aa[4] = {a.x, a.y, a.z, a.w}, bb[4] = {bq.x, bq.y, bq.z, bq.w}, gg[4] = {g.x, g.y, g.z, g.w};
#pragma unroll
      for (int k = 0; k < 4; ++k) {
        int c = half * 8 + 2 * k;
        o[c] = bflo(aa[k]) + bflo(bb[k]);
        o[c + 1] = bfhi(aa[k]) + bfhi(bb[k]);
        gt[c] = bflo(gg[k]);
        gt[c + 1] = bfhi(gg[k]);
        ss += o[c] * o[c] + o[c + 1] * o[c + 1];
      }
    }
    ss = dpp_sum8(ss);
    float rs = rsqrtf(ss * (1.f / 128.f) + EPS);
    uint4 r0, r1;
    unsigned rr[8];
#pragma unroll
    for (int k = 0; k < 8; ++k)
      rr[k] = pack2(o[2 * k] * rs * w[2 * k] * siluf_(gt[2 * k]), o[2 * k + 1] * rs * w[2 * k + 1] * siluf_(gt[2 * k + 1]));
    r0.x = rr[0]; r0.y = rr[1]; r0.z = rr[2]; r0.w = rr[3];
    r1.x = rr[4]; r1.y = rr[5]; r1.z = rr[6]; r1.w = rr[7];
    *(uint4*)hp = r0;
    *(uint4*)(hp + 8) = r1;
  }
}

constexpr int N_PHASES = 17;
#ifndef PH_MASK
#define PH_MASK 0xFFFFFFFFu
#endif
#ifndef DUP_PH
#define DUP_PH -1
#endif
__global__ void __launch_bounds__(256, 2) hybrid_trunk_kernel(Params p) {
  __shared__ __attribute__((aligned(16))) char smem[79872];
  cg::grid_group grid = cg::this_grid();
  __shared__ uint4 xb_words;
  if (threadIdx.x == 0) xb_words = make_uint4(0u, 0u, 0u, 0u);
  __syncthreads();
  XcdBarrier xb = xcd_barrier_post((unsigned*)(p.ws + OFF_BAR), (volatile LAS unsigned*)&xb_words);
  if (p.ph_hi > 1000) grid.sync();
  if constexpr ((PH_MASK >> 0) & 1u) {
    if (p.ph_lo <= 0 && 0 < p.ph_hi) {
      if (0 > p.ph_lo) xcd_barrier(xb);
      phase_prep(p, smem);
      if constexpr (DUP_PH == 0) { grid.sync(); phase_prep(p, smem); }
    }
  }
  if constexpr ((PH_MASK >> 1) & 1u) {
    if (p.ph_lo <= 1 && 1 < p.ph_hi) {
      if (1 > p.ph_lo) xcd_barrier(xb);
      phase_norm(p, 0, 0, false);
      if constexpr (DUP_PH == 1) { grid.sync(); phase_norm(p, 0, 0, false); }
    }
  }
  if constexpr ((PH_MASK >> 2) & 1u) {
    if (p.ph_lo <= 2 && 2 < p.ph_hi) {
      if (2 > p.ph_lo) xcd_barrier(xb);
      phase_gemm_att_in(p, smem);
      if constexpr (DUP_PH == 2) { grid.sync(); phase_gemm_att_in(p, smem); }
    }
  }
  if constexpr ((PH_MASK >> 3) & 1u) {
    if (p.ph_lo <= 3 && 3 < p.ph_hi) {
      if (3 > p.ph_lo) xcd_barrier(xb);
      phase_attn(p, smem);
      if constexpr (DUP_PH == 3) { grid.sync(); phase_attn(p, smem); }
    }
  }
  if constexpr ((PH_MASK >> 4) & 1u) {
    if (p.ph_lo <= 4 && 4 < p.ph_hi) {
      if (4 > p.ph_lo) xcd_barrier(xb);
      phase_gemm_resid(p, smem, (const u16*)(p.ws + OFF_H), 1024, (const u16*)(p.ws + OFF_W_MIX), 1024, 0, 2, true, false);
      if constexpr (DUP_PH == 4) { grid.sync(); phase_gemm_resid(p, smem, (const u16*)(p.ws + OFF_H), 1024, (const u16*)(p.ws + OFF_W_MIX), 1024, 0, 2, true, false); }
    }
  }
  if constexpr ((PH_MASK >> 5) & 1u) {
    if (p.ph_lo <= 5 && 5 < p.ph_hi) {
      if (5 > p.ph_lo) xcd_barrier(xb);
      phase_norm(p, 0, 1, false);
      if constexpr (DUP_PH == 5) { grid.sync(); phase_norm(p, 0, 1, false); }
    }
  }
  if constexpr ((PH_MASK >> 6) & 1u) {
    if (p.ph_lo <= 6 && 6 < p.ph_hi) {
      if (6 > p.ph_lo) xcd_barrier(xb);
      phase_gemm_gu(p, smem, 0, false);
      if constexpr (DUP_PH == 6) { grid.sync(); phase_gemm_gu(p, smem, 0, false); }
    }
  }
  if constexpr ((PH_MASK >> 7) & 1u) {
    if (p.ph_lo <= 7 && 7 < p.ph_hi) {
      if (7 > p.ph_lo) xcd_barrier(xb);
      phase_gemm_resid(p, smem, (const u16*)(p.ws + OFF_BIG), DFF, (const u16*)(p.ws + OFF_W_DN), DFF, 0, 5, false, false);
      if constexpr (DUP_PH == 7) { grid.sync(); phase_gemm_resid(p, smem, (const u16*)(p.ws + OFF_BIG), DFF, (const u16*)(p.ws + OFF_W_DN), DFF, 0, 5, false, false); }
    }
  }
  if constexpr ((PH_MASK >> 8) & 1u) {
    if (p.ph_lo <= 8 && 8 < p.ph_hi) {
      if (8 > p.ph_lo) xcd_barrier(xb);
      phase_norm(p, 1, 2, false);
      if constexpr (DUP_PH == 8) { grid.sync(); phase_norm(p, 1, 2, false); }
    }
  }
  if constexpr ((PH_MASK >> 9) & 1u) {
    if (p.ph_lo <= 9 && 9 < p.ph_hi) {
      if (9 > p.ph_lo) xcd_barrier(xb);
      phase_gemm_rec_in(p, smem);
      if constexpr (DUP_PH == 9) { grid.sync(); phase_gemm_rec_in(p, smem); }
    }
  }
  if constexpr ((PH_MASK >> 10) & 1u) {
    if (p.ph_lo <= 10 && 10 < p.ph_hi) {
      if (10 > p.ph_lo) xcd_barrier(xb);
      phase_scan(p, smem, xb);
      if constexpr (DUP_PH == 10) { xcd_barrier(xb); phase_scan(p, smem, xb); }
    }
  }
  if constexpr ((PH_MASK >> 11) & 1u) {
    if (p.ph_lo <= 11 && 11 < p.ph_hi) {
      if (11 > p.ph_lo) xcd_barrier(xb);
      phase_merge(p);
      if constexpr (DUP_PH == 11) { grid.sync(); phase_merge(p); }
    }
  }
  if constexpr ((PH_MASK >> 12) & 1u) {
    if (p.ph_lo <= 12 && 12 < p.ph_hi) {
      if (12 > p.ph_lo) xcd_barrier(xb);
      phase_gemm_resid(p, smem, (const u16*)(p.ws + OFF_H), 1024, (const u16*)(p.ws + OFF_W_MIX) + (size_t)1024 * 1024, 1024, 1, 2, false, true);
      if constexpr (DUP_PH == 12) { grid.sync(); phase_gemm_resid(p, smem, (const u16*)(p.ws + OFF_H), 1024, (const u16*)(p.ws + OFF_W_MIX) + (size_t)1024 * 1024, 1024, 1, 2, false, true); }
    }
  }
  if constexpr ((PH_MASK >> 13) & 1u) {
    if (p.ph_lo <= 13 && 13 < p.ph_hi) {
      if (13 > p.ph_lo) xcd_barrier(xb);
      phase_norm(p, 1, 1, true);
      if constexpr (DUP_PH == 13) { grid.sync(); phase_norm(p, 1, 1, true); }
    }
  }
  if constexpr ((PH_MASK >> 14) & 1u) {
    if (p.ph_lo <= 14 && 14 < p.ph_hi) {
      if (14 > p.ph_lo) xcd_barrier(xb);
      phase_gemm_gu(p, smem, 1, true);
      if constexpr (DUP_PH == 14) { grid.sync(); phase_gemm_gu(p, smem, 1, true); }
    }
  }
  if constexpr ((PH_MASK >> 15) & 1u) {
    if (p.ph_lo <= 15 && 15 < p.ph_hi) {
      if (15 > p.ph_lo) xcd_barrier(xb);
      phase_gemm_resid(p, smem, (const u16*)(p.ws + OFF_BIG), DFF, (const u16*)(p.ws + OFF_W_DN) + (size_t)1024 * DFF, DFF, 1, 5, false, true);
      if constexpr (DUP_PH == 15) { grid.sync(); phase_gemm_resid(p, smem, (const u16*)(p.ws + OFF_BIG), DFF, (const u16*)(p.ws + OFF_W_DN) + (size_t)1024 * DFF, DFF, 1, 5, false, true); }
    }
  }
  if constexpr ((PH_MASK >> 16) & 1u) {
    if (p.ph_lo <= 16 && 16 < p.ph_hi) {
      if (16 > p.ph_lo) xcd_barrier(xb);
      phase_final(p);
      if constexpr (DUP_PH == 16) { grid.sync(); phase_final(p); }
    }
  }
}

extern "C" void kernel_launch(void* const* d_in, const int* in_sizes, int n_in, void* d_out, int out_size, void* d_ws,
                              size_t ws_size, hipStream_t stream) {
  static int grid_blocks = 0;
  if (!grid_blocks) {
    int dev = 0, cus = 0, per_cu = 0;
    hipGetDevice(&dev);
    hipDeviceGetAttribute(&cus, hipDeviceAttributeMultiprocessorCount, dev);
    hipOccupancyMaxActiveBlocksPerMultiprocessor(&per_cu, hybrid_trunk_kernel, 256, 0);
    if (per_cu > 2) per_cu = 2;
    if (per_cu < 1) per_cu = 1;
    grid_blocks = cus * per_cu;
  }
  if (ws_size < WS_NEED) fprintf(stderr, "workspace too small: %zu < %zu\n", ws_size, (size_t)WS_NEED);
  Params p{};
  const float** pf = (const float**)&p;
  for (int i = 0; i < 24; ++i) pf[i] = (const float*)d_in[i];
  p.out = (float*)d_out;
  p.ws = (char*)d_ws;
#if ONE_LAUNCH
  p.ph_lo = 0;
  p.ph_hi = N_PHASES;
  (void)hipMemsetAsync((char*)d_ws + OFF_BAR, 0, XCD_BAR_WORDS * sizeof(unsigned), stream);
  void* args[] = {&p};
  hipError_t e = hipLaunchCooperativeKernel((const void*)hybrid_trunk_kernel, dim3(grid_blocks), dim3(256), args, 0, stream);
  if (e != hipSuccess) fprintf(stderr, "cooperative launch failed: %s (grid %d)\n", hipGetErrorString(e), grid_blocks);
#else
  for (int ph = 0; ph < N_PHASES; ++ph) {
    p.ph_lo = ph;
    p.ph_hi = ph + 1;
    hipLaunchKernelGGL(hybrid_trunk_kernel, dim3(grid_blocks), dim3(256), 0, stream, p);
  }
#endif
}
```

```cpp
#include <hip/hip_runtime.h>
#include <hip/hip_cooperative_groups.h>
#include <cstdio>
namespace cg = cooperative_groups;

#define DI __device__ __forceinline__
typedef unsigned short u16;
typedef __attribute__((ext_vector_type(8))) short bf16x8;
typedef __attribute__((ext_vector_type(16))) float f32x16;
typedef __attribute__((ext_vector_type(2))) float f32x2;
typedef __attribute__((ext_vector_type(4))) unsigned u32x4;
typedef __attribute__((ext_vector_type(2))) unsigned u32x2;
#define MFMA32(a, b, c) __builtin_amdgcn_mfma_f32_32x32x16_bf16((a), (b), (c), 0, 0, 0)

#ifndef ONE_LAUNCH
#define ONE_LAUNCH 1
#endif

constexpr int NB = 4, SEQ = 8192, CTX = 256, UB = 8448, MROWS = 33792, DM = 1024, DFF = 2816;
constexpr int NPROJ = 4608;
constexpr float LOG2E = 1.4426950408889634f;
constexpr float EPS = 1e-6f;

constexpr size_t SZ_W_ATT = (size_t)3072 * 1024 * 2;
constexpr size_t SZ_W_REC = (size_t)4864 * 1024 * 2;
constexpr size_t SZ_W_MIX = (size_t)2 * 1024 * 1024 * 2;
constexpr size_t SZ_W_GU = (size_t)2 * 5632 * 1024 * 2;
constexpr size_t SZ_W_DN = (size_t)2 * 1024 * 2816 * 2;
constexpr size_t OFF_W_ATT = 0;
constexpr size_t OFF_W_REC = OFF_W_ATT + SZ_W_ATT;
constexpr size_t OFF_W_MIX = OFF_W_REC + SZ_W_REC;
constexpr size_t OFF_W_GU = OFF_W_MIX + SZ_W_MIX;
constexpr size_t OFF_W_DN = OFF_W_GU + SZ_W_GU;
constexpr size_t OFF_MOD = OFF_W_DN + SZ_W_DN;
constexpr size_t OFF_ROPE = OFF_MOD + (size_t)2 * 5 * 6144 * 4;
constexpr size_t OFF_MISC = OFF_ROPE + 128 * 16 * 2 * 4;
constexpr size_t OFF_BAR = OFF_MISC + 8192;
constexpr size_t OFF_XCTX = OFF_BAR + 16384;
constexpr size_t OFF_DAB = OFF_XCTX + (size_t)1024 * 1024 * 4;
constexpr size_t OFF_H = OFF_DAB + (size_t)MROWS * 16 * 4;
constexpr size_t OFF_OB = OFF_H + (size_t)MROWS * 1024 * 2;
constexpr size_t OFF_BIG = OFF_OB + (size_t)MROWS * 1024 * 2;
constexpr size_t OFF_VT = OFF_BIG + (size_t)MROWS * 2048 * 2;
constexpr size_t WS_TOTAL = OFF_BIG + (size_t)MROWS * NPROJ * 2;
constexpr int NSEG_G = 8, SEGC_G = 33, NHO_G = NSEG_G - 1;
constexpr int NSEG_H = 3, SEGC_H = 88, NHO_H = NSEG_H - 1;
constexpr size_t OFF_GS = OFF_W_ATT;
constexpr size_t OFF_HD = OFF_GS + (size_t)32 * NHO_G * 16384 * 4;
constexpr size_t OFF_GP = OFF_W_GU;
constexpr size_t OFF_HS = OFF_GP + (size_t)32 * NHO_G * 16384 * 2;
static_assert(OFF_HD + 32 * NHO_H * 128 * 4 <= OFF_W_MIX, "gdn states must fit in the dead att/rec weight region");
static_assert(OFF_HS + (size_t)32 * NHO_H * 16384 * 4 <= OFF_W_GU + SZ_W_GU / 2, "transitions + HGRN states must fit in layer-0 gate/up");
constexpr size_t WS_NEED = WS_TOTAL;

struct Params {
  const float *x, *c, *ctx, *c_ctx, *ada_w, *ada_b, *norm_mix, *norm_ffn, *w_mix_out, *ffn_gate, *ffn_up, *ffn_down,
      *att_w_in, *att_rpb, *att_lambda, *att_subln, *rec_w_in, *rec_lb_logits, *rec_conv_w, *rec_a_log, *rec_dt_bias,
      *rec_c_norm, *rec_d_norm, *final_norm;
  float* out;
  char* ws;
  int ph_lo, ph_hi;
};

DI u16 f2bf(float x) {
  unsigned u = __float_as_uint(x);
  u += 0x7fffu + ((u >> 16) & 1u);
  return (u16)(u >> 16);
}
DI float bf2f(u16 v) { return __uint_as_float(((unsigned)v) << 16); }
typedef __attribute__((ext_vector_type(2))) __bf16 bf16x2_t;
DI unsigned pack2(float a, float b) {
  f32x2 v = {a, b};
  return __builtin_bit_cast(unsigned, __builtin_convertvector(v, bf16x2_t));
}
DI float bflo(unsigned u) { return __uint_as_float(u << 16); }
DI float bfhi(unsigned u) { return __uint_as_float(u & 0xffff0000u); }
DI int crow(int reg, int h) { return (reg & 3) + 8 * (reg >> 2) + 4 * h; }
DI float sigmoidf_(float x) { return __builtin_amdgcn_rcpf(1.f + __expf(-x)); }
DI float siluf_(float x) { return x * __builtin_amdgcn_rcpf(1.f + __expf(-x)); }
DI float wave_sum(float v) {
#pragma unroll
  for (int o = 32; o > 0; o >>= 1) v += __shfl_xor(v, o);
  return v;
}
template <int CTRL>
DI float dpp_mov(float x) {
  return __builtin_bit_cast(float, __builtin_amdgcn_update_dpp(0, __builtin_bit_cast(int, x), CTRL, 0xF, 0xF, true));
}
DI float dpp_sum8(float x) {
  x += dpp_mov<0xB1>(x);
  x += dpp_mov<0x4E>(x);
  x += dpp_mov<0x141>(x);
  return x;
}
DI float dpp_sum16(float x) {
  x = dpp_sum8(x);
  x += dpp_mov<0x140>(x);
  return x;
}
DI void my_sincos(float a, float& s, float& c) {
  float q = rintf(a * 0.636619772f);
  float r = fmaf(-q, 1.57079637f, a);
  r = fmaf(-q, -4.37113883e-8f, r);
  int qi = ((int)q) & 3;
  float r2 = r * r;
  float sr = r + r * r2 * (-1.6666654611e-1f + r2 * (8.3321608736e-3f + r2 * (-1.9515295891e-4f)));
  float cr = 1.f - 0.5f * r2 + r2 * r2 * (4.166664568298827e-2f + r2 * (-1.388731625493765e-3f + r2 * 2.443315711809948e-5f));
  if (qi == 0) { s = sr; c = cr; }
  else if (qi == 1) { s = cr; c = -sr; }
  else if (qi == 2) { s = -sr; c = -cr; }
  else { s = -cr; c = sr; }
}
DI f32x16 zero16() {
  f32x16 z;
#pragma unroll
  for (int i = 0; i < 16; ++i) z[i] = 0.f;
  return z;
}
DI const float* row_in(const Params& p, int u) {
  int b = u / UB, uu = u - b * UB;
  return uu < CTX ? p.ctx + ((size_t)b * CTX + uu) * DM : p.x + ((size_t)b * SEQ + (uu - CTX)) * DM;
}
DI float* row_cur(const Params& p, int u) {
  int b = u / UB, uu = u - b * UB;
  return uu < CTX ? (float*)(p.ws + OFF_XCTX) + ((size_t)b * CTX + uu) * DM : p.out + ((size_t)b * SEQ + (uu - CTX)) * DM;
}
DI int mod_vec(int u) {
  int b = u / UB, uu = u - b * UB;
  return uu < CTX ? 4 : b;
}

#define XB_TMO      128
#define XB_XCNT(j)  (256  + 64 * (j))
#define XB_XSUB(j)  (1280 + 64 * (j))
#define XB_XGEN(j)  (2304 + 64 * (j))
#define XB_TOP      3328
#define XB_TOPGEN   3392
#define XCD_BAR_WORDS 3456
#define XB_SPIN_CAP (1u << 18)
#define LAS __attribute__((address_space(3)))
DI unsigned xb_ld(unsigned* p) { return __hip_atomic_load(p, __ATOMIC_RELAXED, __HIP_MEMORY_SCOPE_AGENT); }
DI unsigned xb_add(unsigned* p, unsigned v) { return __hip_atomic_fetch_add(p, v, __ATOMIC_RELAXED, __HIP_MEMORY_SCOPE_AGENT); }
DI unsigned xb_xcc_id() { return (unsigned)__builtin_amdgcn_s_getreg((3 << 11) | 20) & 0xFu; }
#define XB_SPIN(cond, bar) do { unsigned _sp = 0; while (cond) { __builtin_amdgcn_s_sleep(1); \
    if ((++_sp & 255u) == 0u) { if (xb_ld(&(bar)[XB_TMO])) break; if (_sp > XB_SPIN_CAP) { atomicAdd(&(bar)[XB_TMO], 1u); break; } } } } while (0)
struct XcdBarrier {
  unsigned* bar;
  unsigned x;
  volatile LAS unsigned* st;
};
DI XcdBarrier xcd_barrier_post(unsigned* bar, volatile LAS unsigned* st) {
  XcdBarrier b;
  b.bar = bar; b.x = xb_xcc_id(); b.st = st;
  if (threadIdx.x == 0) (void)xb_add(&bar[XB_XCNT(b.x)], 1u);
  return b;
}
DI void xcd_barrier_complete(unsigned* bar, unsigned x, unsigned& nloc, unsigned& nx) {
  const unsigned G = gridDim.x * gridDim.y * gridDim.z;
  unsigned sum, cnt, mine, sp = 0u;
  for (;;) {
    sum = 0u; cnt = 0u; mine = 0u;
#pragma unroll
    for (unsigned j = 0; j < 16; ++j) {
      const unsigned c = xb_ld(&bar[XB_XCNT(j)]);
      sum += c; cnt += (c > 0u) ? 1u : 0u; mine = (j == x) ? c : mine;
    }
    if (sum == G) break;
    __builtin_amdgcn_s_sleep(1);
    if ((++sp & 255u) == 0u) { if (xb_ld(&bar[XB_TMO])) break; if (sp > XB_SPIN_CAP) { atomicAdd(&bar[XB_TMO], 1u); break; } }
  }
  nloc = mine > 0u ? mine : 1u; nx = cnt > 0u ? cnt : 1u;
}
DI void xcd_barrier(const XcdBarrier& b) {
  asm volatile("s_waitcnt vmcnt(0)" ::: "memory");
  __syncthreads();
  if (threadIdx.x == 0) {
    unsigned* bar = b.bar;
    __builtin_amdgcn_s_waitcnt(0);
    unsigned nloc = b.st[0], nx = b.st[1];
    if (nloc == 0u) { xcd_barrier_complete(bar, b.x, nloc, nx); b.st[0] = nloc; b.st[1] = nx; }
    const unsigned old = xb_add(&bar[XB_XSUB(b.x)], 1u);
    const unsigned gen = old / nloc;
    if (old + 1u == (gen + 1u) * nloc) {
      __builtin_amdgcn_fence(__ATOMIC_RELEASE, "agent");
      asm volatile("s_waitcnt vmcnt(0)" ::: "memory");
      const unsigned og = xb_add(&bar[XB_TOP], 1u);
      const unsigned tg = og / nx;
      if (og + 1u == (tg + 1u) * nx) xb_add(&bar[XB_TOPGEN], 1u);
      else XB_SPIN(xb_ld(&bar[XB_TOPGEN]) == tg, bar);
      __builtin_amdgcn_fence(__ATOMIC_ACQUIRE, "agent");
      xb_add(&bar[XB_XGEN(b.x)], 1u);
      asm volatile("s_waitcnt vmcnt(0)" ::: "memory");
    } else {
      XB_SPIN(xb_ld(&bar[XB_XGEN(b.x)]) == gen, bar);
      __builtin_amdgcn_fence(__ATOMIC_ACQUIRE, "agent");
      asm volatile("s_waitcnt vmcnt(0)" ::: "memory");
    }
  }
  __syncthreads();
}

template <class F>
DI void conv_tile(float* tile, int k0, int n0, int K, u16* __restrict__ dst, F srcf) {
  const int tid = threadIdx.x;
#pragma unroll 4
  for (int i = 0; i < 16; ++i) {
    int idx = i * 256 + tid, kk = idx >> 6, nn = idx & 63;
    tile[kk * 65 + nn] = srcf(k0 + kk, n0 + nn);
  }
  __syncthreads();
#pragma unroll 4
  for (int i = 0; i < 8; ++i) {
    int idx = i * 256 + tid, nn = idx >> 5, kk = (idx & 31) * 2;
    *(unsigned*)(dst + (size_t)(n0 + nn) * K + k0 + kk) = pack2(tile[kk * 65 + nn], tile[(kk + 1) * 65 + nn]);
  }
  __syncthreads();
}

DI void phase_prep(const Params& p, char* smem) {
  const int tid = threadIdx.x;
  float* fs = (float*)smem;
  const int N_CONV = 768 + 1216 + 512 + 2816 + 1408;
  const int N_ITEMS = N_CONV + 192 + 1;
  for (int item = blockIdx.x; item < N_ITEMS; item += gridDim.x) {
    if (item < 768) {
      int kt = item / 48, nt = item % 48;
      const float* src = p.att_w_in;
      conv_tile(fs, kt * 64, nt * 64, 1024, (u16*)(p.ws + OFF_W_ATT), [&](int k, int n) {
        int seg = n >> 9;
        int sseg = seg == 2 ? 3 : seg == 3 ? 4 : seg == 4 ? 2 : seg;
        return src[(size_t)k * 3072 + sseg * 512 + (n & 511)];
      });
    } else if (item < 768 + 1216) {
      int it = item - 768, kt = it / 76, nt = it % 76;
      const float* src = p.rec_w_in;
      conv_tile(fs, kt * 64, nt * 64, 1024, (u16*)(p.ws + OFF_W_REC),
                [&](int k, int n) { return n < 4624 ? src[(size_t)k * 4624 + n] : 0.f; });
    } else if (item < 768 + 1216 + 512) {
      int it = item - 1984, l = it / 256, r = it % 256, kt = r / 16, nt = r % 16;
      const float* src = p.w_mix_out + (size_t)l * 1024 * 1024;
      conv_tile(fs, kt * 64, nt * 64, 1024, (u16*)(p.ws + OFF_W_MIX) + (size_t)l * 1024 * 1024,
                [&](int k, int n) { return src[(size_t)k * 1024 + n]; });
    } else if (item < 768 + 1216 + 512 + 2816) {
      int it = item - 2496, l = it / 1408, r = it % 1408, kt = r / 88, nt = r % 88;
      const float* sg = p.ffn_gate + (size_t)l * 1024 * DFF;
      const float* su = p.ffn_up + (size_t)l * 1024 * DFF;
      conv_tile(fs, kt * 64, nt * 64, 1024, (u16*)(p.ws + OFF_W_GU) + (size_t)l * 5632 * 1024, [&](int k, int n) {
        int blk = n >> 6, r6 = n & 63;
        return r6 < 32 ? sg[(size_t)k * DFF + blk * 32 + r6] : su[(size_t)k * DFF + blk * 32 + r6 - 32];
      });
    } else if (item < N_CONV) {
      int it = item - 5312, l = it / 704, r = it % 704, kt = r / 16, nt = r % 16;
      const float* src = p.ffn_down + (size_t)l * DFF * 1024;
      conv_tile(fs, kt * 64, nt * 64, DFF, (u16*)(p.ws + OFF_W_DN) + (size_t)l * 1024 * DFF,
                [&](int k, int n) { return src[(size_t)k * 1024 + n]; });
    } else if (item < N_CONV + 192) {
      int it = item - N_CONV, l = it / 96, cb = it % 96;
      float* s = fs;
      float* red = fs + 5 * 1024;
      for (int i = tid; i < 5 * 1024; i += 256) {
        int v = i >> 10, k = i & 1023;
        float cv = v < 4 ? p.c[v * 1024 + k] : p.c_ctx[k];
        s[i] = siluf_(cv);
      }
      __syncthreads();
      int ci = tid & 63, kg = tid >> 6, col = cb * 64 + ci;
      float acc[5] = {0.f, 0.f, 0.f, 0.f, 0.f};
      const float* w = p.ada_w + (size_t)l * 1024 * 6144 + col;
      for (int k = kg; k < 1024; k += 4) {
        float wv = w[(size_t)k * 6144];
#pragma unroll
        for (int v = 0; v < 5; ++v) acc[v] += s[v * 1024 + k] * wv;
      }
#pragma unroll
      for (int v = 0; v < 5; ++v) red[(kg * 5 + v) * 64 + ci] = acc[v];
      __syncthreads();
      if (kg == 0) {
        float* mod = (float*)(p.ws + OFF_MOD);
#pragma unroll
        for (int v = 0; v < 5; ++v) {
          float t = red[(0 * 5 + v) * 64 + ci] + red[(1 * 5 + v) * 64 + ci] + red[(2 * 5 + v) * 64 + ci] + red[(3 * 5 + v) * 64 + ci];
          mod[(size_t)(l * 5 + v) * 6144 + col] = t + p.ada_b[l * 6144 + col];
        }
      }
      __syncthreads();
    } else {
      float* rope = (float*)(p.ws + OFF_ROPE);
      float* misc = (float*)(p.ws + OFF_MISC);
      for (int i = tid; i < 128 * 16; i += 256) {
        int pos = i >> 4, fi = i & 15;
        float invf = exp2f(-(float)fi * (13.287712379549449f / 16.f));
        float s, c;
        my_sincos((float)pos * invf, s, c);
        rope[i * 2] = c;
        rope[i * 2 + 1] = s;
      }
      for (int i = tid; i < 1024; i += 256) {
        float l0 = p.rec_lb_logits[i], l1 = p.rec_lb_logits[1024 + i];
        misc[16 + i] = 1.f / (1.f + expf(l0 - l1));
      }
      if (tid < 64) {
        float a = p.att_lambda[tid] * p.att_lambda[64 + tid];
        float b = p.att_lambda[128 + tid] * p.att_lambda[192 + tid];
        a = wave_sum(a);
        b = wave_sum(b);
        if (tid == 0) misc[0] = expf(a) - expf(b) + 0.2f;
      }
    }
  }
}

DI void norm_row(const float* __restrict__ src, const float* __restrict__ w, const float* __restrict__ shift,
                 const float* __restrict__ scale, u16* __restrict__ dst, int lane) {
  float4 v[4];
  float ss = 0.f;
#pragma unroll
  for (int i = 0; i < 4; ++i) {
    v[i] = ((const float4*)src)[lane + i * 64];
    ss += v[i].x * v[i].x + v[i].y * v[i].y + v[i].z * v[i].z + v[i].w * v[i].w;
  }
  ss = wave_sum(ss);
  float rs = rsqrtf(ss * (1.f / 1024.f) + EPS);
#pragma unroll
  for (int i = 0; i < 4; ++i) {
    int c4 = lane + i * 64;
    float4 ww = ((const float4*)w)[c4], sh = ((const float4*)shift)[c4], sc = ((const float4*)scale)[c4];
    float a = v[i].x * rs * ww.x * (1.f + sc.x) + sh.x;
    float b = v[i].y * rs * ww.y * (1.f + sc.y) + sh.y;
    float c = v[i].z * rs * ww.z * (1.f + sc.z) + sh.z;
    float d = v[i].w * rs * ww.w * (1.f + sc.w) + sh.w;
    uint2 o;
    o.x = pack2(a, b);
    o.y = pack2(c, d);
    ((uint2*)dst)[c4] = o;
  }
}
DI void phase_norm(const Params& p, int layer, int which, bool skip_ctx) {
  const int lane = threadIdx.x & 63, wave = threadIdx.x >> 6;
  const float* mod = (const float*)(p.ws + OFF_MOD);
  u16* H = (u16*)(p.ws + OFF_H);
  for (int item = blockIdx.x; item < MROWS / 4; item += gridDim.x) {
    int u = item * 4 + wave;
    int uu = u % UB;
    if (skip_ctx && uu < CTX) continue;
    const float* src = (which == 0) ? row_in(p, u) : row_cur(p, u);
    const float* w = (which == 1 ? p.norm_ffn : p.norm_mix) + layer * 1024;
    const float* mv = mod + (size_t)(layer * 5 + mod_vec(u)) * 6144 + (which == 1 ? 3 * 1024 : 0);
    norm_row(src, w, mv, mv + 1024, H + (size_t)u * 1024, lane);
  }
}
DI void phase_final(const Params& p) {
  const int lane = threadIdx.x & 63, wave = threadIdx.x >> 6;
  for (int item = blockIdx.x; item < NB * SEQ / 4; item += gridDim.x) {
    float* row = p.out + (size_t)(item * 4 + wave) * 1024;
    float4 v[4];
    float ss = 0.f;
#pragma unroll
    for (int i = 0; i < 4; ++i) {
      v[i] = ((const float4*)row)[lane + i * 64];
      ss += v[i].x * v[i].x + v[i].y * v[i].y + v[i].z * v[i].z + v[i].w * v[i].w;
    }
    ss = wave_sum(ss);
    float rs = rsqrtf(ss * (1.f / 1024.f) + EPS);
#pragma unroll
    for (int i = 0; i < 4; ++i) {
      float4 ww = ((const float4*)p.final_norm)[lane + i * 64];
      float4 o;
      o.x = v[i].x * rs * ww.x; o.y = v[i].y * rs * ww.y; o.z = v[i].z * rs * ww.z; o.w = v[i].w * rs * ww.w;
      ((float4*)row)[lane + i * 64] = o;
    }
  }
}

DI bool gemm_tile_of(int it, int NT, int& mt, int& nt) {
  if ((gridDim.x & 7) != 0) {
    int item = it * gridDim.x + blockIdx.x;
    if (item >= 264 * NT) return false;
    mt = item / NT; nt = item % NT;
    return true;
  }
  const int xcd = blockIdx.x & 7, lw = blockIdx.x >> 3, wpx = gridDim.x >> 3;
  int idx = it * wpx + lw;
  if (idx >= 33 * NT) return false;
  const int nfull = NT >> 3, full_items = nfull * 33 * 8;
  int ml;
  if (idx < full_items) {
    int nb = idx / 264, rem = idx - nb * 264;
    ml = rem >> 3; nt = nb * 8 + (rem & 7);
  } else {
    int i2 = idx - full_items, w = NT - nfull * 8;
    ml = i2 / w; nt = nfull * 8 + (i2 - ml * w);
  }
  mt = xcd * 33 + ml;
  return true;
}

DI void gemm_core(const u16* __restrict__ A, int lda, const u16* __restrict__ Wt, int K, int m0, int n0, char* smem,
                  f32x16 (&acc)[2][2]) {
  u16* As = (u16*)smem;
  u16* Bs = As + 2 * 128 * 72;
  const int tid = threadIdx.x, lane = tid & 63, wave = tid >> 6;
  const int wm = (wave >> 1) * 64, wn = (wave & 1) * 64;
  const int r = lane & 31, h = lane >> 5;
#pragma unroll
  for (int i = 0; i < 2; ++i)
#pragma unroll
    for (int j = 0; j < 2; ++j) acc[i][j] = zero16();
  u32x4 ra0[4], rb0[4], ra1[4], rb1[4];
  const int lrow = tid >> 3, lcc = (tid & 7) * 8;
  const u16* ag = A + (size_t)(m0 + lrow) * lda + lcc;
  const u16* bg = Wt + (size_t)(n0 + lrow) * K + lcc;
  const int nk = K >> 6;
#define GLOAD(RA, RB, KT)                                                   \
  _Pragma("unroll") for (int i = 0; i < 4; ++i) {                           \
    RA[i] = *(const u32x4*)(ag + (size_t)(i * 32) * lda + (KT) * 64);       \
    RB[i] = *(const u32x4*)(bg + (size_t)(i * 32) * K + (KT) * 64);         \
  }
#define SSTORE(RA, RB, BUF)                                                 \
  _Pragma("unroll") for (int i = 0; i < 4; ++i) {                           \
    *(u32x4*)(As + (BUF) * 128 * 72 + (lrow + i * 32) * 72 + lcc) = RA[i];  \
    *(u32x4*)(Bs + (BUF) * 128 * 72 + (lrow + i * 32) * 72 + lcc) = RB[i];  \
  }
#define COMPUTE(BUF)                                                                        \
  _Pragma("unroll") for (int ks = 0; ks < 4; ++ks) {                                        \
    const u16* as = As + (BUF) * 128 * 72;                                                  \
    const u16* bs = Bs + (BUF) * 128 * 72;                                                  \
    bf16x8 a0 = *(const bf16x8*)(as + (wm + r) * 72 + ks * 16 + h * 8);                     \
    bf16x8 a1 = *(const bf16x8*)(as + (wm + 32 + r) * 72 + ks * 16 + h * 8);                \
    bf16x8 b0 = *(const bf16x8*)(bs + (wn + r) * 72 + ks * 16 + h * 8);                     \
    bf16x8 b1 = *(const bf16x8*)(bs + (wn + 32 + r) * 72 + ks * 16 + h * 8);                \
    acc[0][0] = MFMA32(a0, b0, acc[0][0]);                                                  \
    acc[0][1] = MFMA32(a0, b1, acc[0][1]);                                                  \
    acc[1][0] = MFMA32(a1, b0, acc[1][0]);                                                  \
    acc[1][1] = MFMA32(a1, b1, acc[1][1]);                                                  \
  }
  GLOAD(ra0, rb0, 0)
  GLOAD(ra1, rb1, 1)
  __syncthreads();
  SSTORE(ra0, rb0, 0)
  __syncthreads();
  if (nk > 2) { GLOAD(ra0, rb0, 2) }
  for (int it = 0; it < nk; it += 2) {
    COMPUTE(0)
    SSTORE(ra1, rb1, 1)
    __syncthreads();
    if (it + 3 < nk) { GLOAD(ra1, rb1, it + 3) }
    COMPUTE(1)
    if (it + 2 < nk) { SSTORE(ra0, rb0, 0) }
    __syncthreads();
    if (it + 4 < nk) { GLOAD(ra0, rb0, it + 4) }
  }
#undef GLOAD
#undef SSTORE
#undef COMPUTE
}

DI void gemm_core256(const u16* __restrict__ A, int lda, const u16* __restrict__ Wt, int K, int m0, int n0, char* smem,
                     f32x16 (&acc)[2][4]) {
  constexpr int PT = 40;
  u16* As = (u16*)smem;
  u16* Bs = As + 2 * 128 * PT;
  const int tid = threadIdx.x, lane = tid & 63, wave = tid >> 6;
  const int wm = (wave >> 1) * 64, wn = (wave & 1) * 128;
  const int r = lane & 31, h = lane >> 5;
#pragma unroll
  for (int i = 0; i < 2; ++i)
#pragma unroll
    for (int j = 0; j < 4; ++j) acc[i][j] = zero16();
  u32x4 ra0[2], rb0[4], ra1[2], rb1[4];
  const int lrow = tid >> 2, lcc = (tid & 3) * 8;
  const u16* ag = A + (size_t)(m0 + lrow) * lda + lcc;
  const u16* bg = Wt + (size_t)(n0 + lrow) * K + lcc;
  const int nk = K >> 5;
#define GLOAD(RA, RB, KT)                                                                          \
  _Pragma("unroll") for (int i = 0; i < 2; ++i) RA[i] = *(const u32x4*)(ag + (size_t)(i * 64) * lda + (KT) * 32); \
  _Pragma("unroll") for (int i = 0; i < 4; ++i) RB[i] = *(const u32x4*)(bg + (size_t)(i * 64) * K + (KT) * 32);
#define SSTORE(RA, RB, BUF)                                                                        \
  _Pragma("unroll") for (int i = 0; i < 2; ++i) *(u32x4*)(As + (BUF) * 128 * PT + (lrow + i * 64) * PT + lcc) = RA[i]; \
  _Pragma("unroll") for (int i = 0; i < 4; ++i) *(u32x4*)(Bs + (BUF) * 256 * PT + (lrow + i * 64) * PT + lcc) = RB[i];
#define COMPUTE(BUF)                                                                               \
  _Pragma("unroll") for (int ks = 0; ks < 2; ++ks) {                                               \
    const u16* as = As + (BUF) * 128 * PT;                                                         \
    const u16* bs = Bs + (BUF) * 256 * PT;                                                         \
    bf16x8 a0 = *(const bf16x8*)(as + (wm + r) * PT + ks * 16 + h * 8);                            \
    bf16x8 a1 = *(const bf16x8*)(as + (wm + 32 + r) * PT + ks * 16 + h * 8);                       \
    _Pragma("unroll") for (int j = 0; j < 4; ++j) {                                                \
      bf16x8 bj = *(const bf16x8*)(bs + (wn + 32 * j + r) * PT + ks * 16 + h * 8);                 \
      acc[0][j] = MFMA32(a0, bj, acc[0][j]);                                                       \
      acc[1][j] = MFMA32(a1, bj, acc[1][j]);                                                       \
    }                                                                                              \
  }
  GLOAD(ra0, rb0, 0)
  GLOAD(ra1, rb1, 1)
  __syncthreads();
  SSTORE(ra0, rb0, 0)
  __syncthreads();
  if (nk > 2) { GLOAD(ra0, rb0, 2) }
  for (int it = 0; it < nk; it += 2) {
    COMPUTE(0)
    SSTORE(ra1, rb1, 1)
    __syncthreads();
    if (it + 3 < nk) { GLOAD(ra1, rb1, it + 3) }
    COMPUTE(1)
    if (it + 2 < nk) { SSTORE(ra0, rb0, 0) }
    __syncthreads();
    if (it + 4 < nk) { GLOAD(ra0, rb0, it + 4) }
  }
#undef GLOAD
#undef SSTORE
#undef COMPUTE
}

DI void phase_gemm_att_in(const Params& p, char* smem) {
  const u16* H = (const u16*)(p.ws + OFF_H);
  const u16* W = (const u16*)(p.ws + OFF_W_ATT);
  u16* QK = (u16*)(p.ws + OFF_BIG);
  u16* VT = (u16*)(p.ws + OFF_VT);
  const float* rope = (const float*)(p.ws + OFF_ROPE);
  const int lane = threadIdx.x & 63, wave = threadIdx.x >> 6;
  const int wm = (wave >> 1) * 64, wn = (wave & 1) * 64, r = lane & 31, h = lane >> 5;
  const int NT = 24, MT = MROWS / 128;
  for (int it = 0;; ++it) {
    int mt, nt;
    if (!gemm_tile_of(it, NT, mt, nt)) break;
    int m0 = mt * 128, n0 = nt * 128;
    f32x16 acc[2][2];
    gemm_core(H, 1024, W, 1024, m0, n0, smem, acc);
    int seg = n0 >> 9;
    int b = m0 / UB, uu0 = m0 - b * UB;
    bool lat = uu0 >= CTX;
    if (seg < 4) {
      bool dorope = lat && seg >= 2;
#pragma unroll
      for (int i = 0; i < 2; ++i)
#pragma unroll
        for (int j = 0; j < 2; ++j) {
          int n = n0 + wn + 32 * j + r;
#pragma unroll
          for (int g = 0; g < 16; ++g) {
            int mrow = m0 + wm + 32 * i + crow(g, h);
            float v = acc[i][j][g];
            if (seg >= 2) {
              float pv = __shfl_xor(v, 16);
              if (dorope) {
                int t = uu0 + wm + 32 * i + crow(g, h) - CTX;
                int pos = (j == 0) ? (t >> 6) : (t & 63);
                float2 cs = ((const float2*)rope)[pos * 16 + (r & 15)];
                v = v * cs.x + ((r < 16) ? -pv : pv) * cs.y;
              }
            }
            QK[(size_t)mrow * 2048 + n] = f2bf(v);
          }
        }
    } else {
#pragma unroll
      for (int i = 0; i < 2; ++i)
#pragma unroll
        for (int j = 0; j < 2; ++j) {
          int vc = n0 - 2048 + wn + 32 * j + r;
          u16* vrow = VT + ((size_t)b * 1024 + vc) * UB;
#pragma unroll
          for (int g4 = 0; g4 < 4; ++g4) {
            int tok = uu0 + wm + 32 * i + 8 * g4 + 4 * h;
            uint2 o;
            o.x = pack2(acc[i][j][4 * g4], acc[i][j][4 * g4 + 1]);
            o.y = pack2(acc[i][j][4 * g4 + 2], acc[i][j][4 * g4 + 3]);
            *(uint2*)(vrow + tok) = o;
          }
        }
    }
  }
}

DI void phase_gemm_resid(const Params& p, char* smem, const u16* A, int lda, const u16* W, int K, int layer, int gate_chunk,
                         bool first, bool skip_ctx) {
  const float* mod = (const float*)(p.ws + OFF_MOD);
  const int lane = threadIdx.x & 63, wave = threadIdx.x >> 6;
  const int wm = (wave >> 1) * 64, wn = (wave & 1) * 64, r = lane & 31, h = lane >> 5;
  const int NT = 8, MT = MROWS / 128;
  for (int it = 0;; ++it) {
    int mt, nt;
    if (!gemm_tile_of(it, NT, mt, nt)) break;
    if (skip_ctx && (mt % 66) < 2) continue;
    int m0 = mt * 128, n0 = nt * 128;
    f32x16 acc[2][2];
    gemm_core(A, lda, W, K, m0, n0, smem, acc);
    const float* gv = mod + (size_t)(layer * 5 + mod_vec(m0)) * 6144 + gate_chunk * 1024;
    const float* src0 = (first ? row_in(p, m0) : row_cur(p, m0)) + n0 + wn + r;
    float* dst0 = row_cur(p, m0) + n0 + wn + r;
    const float g0 = gv[n0 + wn + r], g1 = gv[n0 + wn + 32 + r];
    int hq = h;
    asm volatile("" : "+v"(hq));
#pragma unroll
    for (int i = 0; i < 2; ++i)
#pragma unroll
      for (int g = 0; g < 16; ++g) {
        const int ro = (wm + 32 * i + crow(g, hq)) * 1024;
        dst0[ro] = src0[ro] + g0 * acc[i][0][g];
        dst0[ro + 32] = src0[ro + 32] + g1 * acc[i][1][g];
      }
  }
}

DI void phase_gemm_gu(const Params& p, char* smem, int layer, bool skip_ctx) {
  const u16* H = (const u16*)(p.ws + OFF_H);
  const u16* W = (const u16*)(p.ws + OFF_W_GU) + (size_t)layer * 5632 * 1024;
  u16* ACT = (u16*)(p.ws + OFF_BIG);
  const int lane = threadIdx.x & 63, wave = threadIdx.x >> 6;
  const int wm = (wave >> 1) * 64, wn = (wave & 1) * 128, r = lane & 31, h = lane >> 5;
  const int NT = 22;
  for (int it = 0;; ++it) {
    int mt, nt;
    if (!gemm_tile_of(it, NT, mt, nt)) break;
    if (skip_ctx && (mt % 66) < 2) continue;
    int m0 = mt * 128, n0 = nt * 256;
    f32x16 acc[2][4];
    gemm_core256(H, 1024, W, 1024, m0, n0, smem, acc);
    int col = ((n0 + wn) >> 1) + r;
#pragma unroll
    for (int i = 0; i < 2; ++i)
#pragma unroll
      for (int g = 0; g < 16; ++g) {
        int mrow = m0 + wm + 32 * i + crow(g, h);
        ACT[(size_t)mrow * DFF + col] = f2bf(siluf_(acc[i][0][g]) * acc[i][1][g]);
        ACT[(size_t)mrow * DFF + col + 32] = f2bf(siluf_(acc[i][2][g]) * acc[i][3][g]);
      }
  }
}

DI void phase_gemm_rec_in(const Params& p, char* smem) {
  const u16* H = (const u16*)(p.ws + OFF_H);
  const u16* W = (const u16*)(p.ws + OFF_W_REC);
  u16* PROJ = (u16*)(p.ws + OFF_BIG);
  float* DAB = (float*)(p.ws + OFF_DAB);
  const int lane = threadIdx.x & 63, wave = threadIdx.x >> 6;
  const int wm = (wave >> 1) * 64, wn = (wave & 1) * 128, r = lane & 31, h = lane >> 5;
  const int NT = 19;
  for (int it = 0;; ++it) {
    int mt, nt;
    if (!gemm_tile_of(it, NT, mt, nt)) break;
    int m0 = mt * 128, n0 = nt * 256;
    f32x16 acc[2][4];
    gemm_core256(H, 1024, W, 1024, m0, n0, smem, acc);
#pragma unroll
    for (int i = 0; i < 2; ++i)
#pragma unroll
      for (int j = 0; j < 4; ++j) {
        int n = n0 + wn + 32 * j + r;
#pragma unroll
        for (int g = 0; g < 16; ++g) {
          int mrow = m0 + wm + 32 * i + crow(g, h);
          float v = acc[i][j][g];
          if (n < 4096) PROJ[(size_t)mrow * NPROJ + n] = f2bf(v);
          else if (n >= 4112 && n < 4624) PROJ[(size_t)mrow * NPROJ + n - 16] = f2bf(v);
        }
      }
    if (n0 + wn == 4096 && r < 16) {
      const float dtb = p.rec_dt_bias[r & 7], ar = expf(p.rec_a_log[r & 7]);
#pragma unroll
      for (int i = 0; i < 2; ++i)
#pragma unroll
        for (int g = 0; g < 16; ++g) {
          const int mrow = m0 + wm + 32 * i + crow(g, h);
          const float v = acc[i][0][g];
          float o;
          if (r < 8) {
            const float xx = v + dtb;
            const float sp = xx > 20.f ? xx : log1pf(expf(xx));
            o = -ar * sp;
          } else {
            o = 1.f / (1.f + expf(-v));
          }
          DAB[(size_t)mrow * 16 + r] = o;
        }
    }
  }
}

constexpr int ATT_KS = 64 * 72;
template <int DV>
DI void attn_job(const u16* __restrict__ qk, size_t qrow, int qcol, int kcol, size_t kbase, const u16* __restrict__ vt,
                 int s0, int n0, int s1, int n1, bool na, int na_rlo, int na_r0w, int na_rq, int na_qc,
                 const float* rpb_lds, char* smem, f32x16 (&O)[DV / 32], float& l_out) {
  u16* Ks = (u16*)smem;
  u16* Vs = Ks + 2 * ATT_KS;
  constexpr int NV = DV / 32;
  const int tid = threadIdx.x, lane = tid & 63, r = lane & 31, h = lane >> 5;
  bf16x8 qf[4];
#pragma unroll
  for (int s = 0; s < 4; ++s) qf[s] = *(const bf16x8*)(qk + (qrow + r) * 2048 + qcol + 16 * s + 8 * h);
#pragma unroll
  for (int d = 0; d < NV; ++d) O[d] = zero16();
  float m = -1e30f, l = 0.f;
  const float sc = 0.125f * LOG2E;
  const int nt = n0 + n1;
  const int lrow = tid >> 3, lcc = (tid & 7) * 8;
  u32x4 rk[2], rv[NV];
  auto gload = [&](int t) {
    const int tok0 = t < n0 ? s0 + 64 * t : s1 + 64 * (t - n0);
#pragma unroll
    for (int i = 0; i < 2; ++i) rk[i] = *(const u32x4*)(qk + (kbase + tok0 + lrow + 32 * i) * 2048 + kcol + lcc);
#pragma unroll
    for (int i = 0; i < NV; ++i) rv[i] = *(const u32x4*)(vt + (size_t)(lrow + 32 * i) * UB + tok0 + lcc);
  };
  auto sstore = [&](int buf) {
#pragma unroll
    for (int i = 0; i < 2; ++i) *(u32x4*)(Ks + buf * ATT_KS + (lrow + 32 * i) * 72 + lcc) = rk[i];
#pragma unroll
    for (int i = 0; i < NV; ++i) *(u32x4*)(Vs + buf * DV * 72 + (lrow + 32 * i) * 72 + lcc) = rv[i];
  };
  gload(0);
  sstore(0);
  __syncthreads();
  for (int t = 0; t < nt; ++t) {
    const int buf = t & 1;
    if (t + 1 < nt) gload(t + 1);
    bool active = true;
    int kr = 0;
    if (na && t >= n0) {
      kr = na_rlo + (t - n0);
      active = (kr >= na_r0w) && (kr < na_r0w + 8);
    }
    if (active) {
      const u16* kb = Ks + buf * ATT_KS;
      const u16* vb = Vs + buf * DV * 72;
      f32x16 S0 = zero16(), S1 = zero16();
#pragma unroll
      for (int s = 0; s < 4; ++s) {
        bf16x8 a0 = *(const bf16x8*)(kb + r * 72 + 16 * s + 8 * h);
        bf16x8 a1 = *(const bf16x8*)(kb + (32 + r) * 72 + 16 * s + 8 * h);
        S0 = MFMA32(a0, qf[s], S0);
        S1 = MFMA32(a1, qf[s], S1);
      }
      float tv[32];
#pragma unroll
      for (int i = 0; i < 16; ++i) {
        tv[i] = S0[i] * sc;
        tv[16 + i] = S1[i] * sc;
      }
      if (na && t >= n0) {
        const int cs = min(max(na_qc - 8, 0), 48);
        const float* brow = rpb_lds + (kr - na_rq + 7) * 31;
#pragma unroll
        for (int i = 0; i < 32; ++i) {
          int kc = (i >> 4) * 32 + crow(i & 15, h);
          bool ok = (kc >= cs) && (kc < cs + 16);
          int ci = min(max(kc - na_qc + 15, 0), 30);
          float bias = brow[ci];
          tv[i] = ok ? tv[i] + bias * LOG2E : -1e30f;
        }
      }
      float tm = tv[0];
#pragma unroll
      for (int i = 1; i < 32; ++i) tm = fmaxf(tm, tv[i]);
      {
        auto rr = __builtin_amdgcn_permlane32_swap(__float_as_uint(tm), __float_as_uint(tm), false, false);
        tm = fmaxf(__uint_as_float(rr[0]), __uint_as_float(rr[1]));
      }
      float mn = m;
      if (!__all(tm - m <= 8.f)) {
        mn = fmaxf(m, tm);
        const float alpha = __builtin_amdgcn_exp2f(m - mn);
        m = mn;
        l *= alpha;
#pragma unroll
        for (int d = 0; d < NV; ++d)
#pragma unroll
          for (int i = 0; i < 16; ++i) O[d][i] *= alpha;
      }
      float ps = 0.f;
#pragma unroll
      for (int i = 0; i < 32; ++i) {
        tv[i] = __builtin_amdgcn_exp2f(tv[i] - mn);
        ps += tv[i];
      }
      l += ps;
      bf16x8 pf[4];
#pragma unroll
      for (int s = 0; s < 4; ++s) {
        u32x4 u;
        u.x = pack2(tv[8 * s], tv[8 * s + 1]);
        u.y = pack2(tv[8 * s + 2], tv[8 * s + 3]);
        u.z = pack2(tv[8 * s + 4], tv[8 * s + 5]);
        u.w = pack2(tv[8 * s + 6], tv[8 * s + 7]);
        pf[s] = __builtin_bit_cast(bf16x8, u);
      }
#pragma unroll
      for (int d = 0; d < NV; ++d) {
        const u16* vp = vb + (32 * d + r) * 72 + 4 * h;
#pragma unroll
        for (int s = 0; s < 4; ++s) {
          u32x2 lo = *(const u32x2*)(vp + 16 * s);
          u32x2 hi = *(const u32x2*)(vp + 16 * s + 8);
          u32x4 u;
          u.x = lo.x; u.y = lo.y; u.z = hi.x; u.w = hi.y;
          O[d] = MFMA32(__builtin_bit_cast(bf16x8, u), pf[s], O[d]);
        }
      }
    }
    if (t + 1 < nt) sstore(buf ^ 1);
    __syncthreads();
  }
  l_out = l + __shfl_xor(l, 32);
}

DI void phase_attn(const Params& p, char* smem) {
  const u16* QK = (const u16*)(p.ws + OFF_BIG);
  const u16* VT = (const u16*)(p.ws + OFF_VT);
  u16* Y = (u16*)(p.ws + OFF_H);
  const float lam = ((const float*)(p.ws + OFF_MISC))[0];
  float* rpb_lds = (float*)(smem + 2 * (ATT_KS + 128 * 72) * 2);
  const int tid = threadIdx.x, lane = tid & 63, wave = tid >> 6, r = lane & 31, h = lane >> 5;
  const int N_A = 1024, N_B = 2048, N_D = 32, N_C = 64;
  for (int item = blockIdx.x; item < N_A + N_B + N_D + N_C; item += gridDim.x) {
    const bool is_diff = item < N_A || (item >= N_A + N_B && item < N_A + N_B + N_D);
    if (is_diff) {
      int b, hd, uu, ntile;
      if (item < N_A) {
        int grp = item >> 6, qt = item & 63;
        if ((gridDim.x & 7) == 0 && gridDim.x >= 512) {
          int lin = (item / (int)gridDim.x) * (gridDim.x >> 3) + (blockIdx.x >> 3);
          grp = (blockIdx.x & 7) + 8 * (lin >> 6);
          qt = lin & 63;
        }
        b = grp >> 2; hd = grp & 3;
        uu = CTX + qt * 128 + wave * 32;
        ntile = UB / 64;
      } else {
        int it = item - N_A - N_B;
        b = it >> 3; hd = (it >> 1) & 3;
        uu = (it & 1) * 128 + wave * 32;
        ntile = CTX / 64;
      }
      const u16* vt = VT + ((size_t)b * 1024 + 512 + hd * 128) * UB;
      f32x16 O[4];
      float l;
      u16* yrow = Y + ((size_t)b * UB + uu + r) * 1024 + 512 + hd * 128;
      attn_job<128>(QK, (size_t)b * UB + uu, 1024 + hd * 128, 1536 + hd * 128, (size_t)b * UB, vt, 0, ntile, 0, 0, false, 0, 0, 0,
                    0, nullptr, smem, O, l);
      {
        float inv = 1.f / l;
#pragma unroll
        for (int d = 0; d < 4; ++d)
#pragma unroll
          for (int g4 = 0; g4 < 4; ++g4) {
            u32x2 o;
            o.x = pack2(O[d][4 * g4] * inv, O[d][4 * g4 + 1] * inv);
            o.y = pack2(O[d][4 * g4 + 2] * inv, O[d][4 * g4 + 3] * inv);
            *(u32x2*)(yrow + 32 * d + 8 * g4 + 4 * h) = o;
          }
      }
      attn_job<128>(QK, (size_t)b * UB + uu, 1024 + hd * 128 + 64, 1536 + hd * 128 + 64, (size_t)b * UB, vt, 0, ntile, 0, 0, false,
                    0, 0, 0, 0, nullptr, smem, O, l);
      float f = lam / l;
      float ss = 0.f;
#pragma unroll
      for (int d = 0; d < 4; ++d)
#pragma unroll
        for (int g4 = 0; g4 < 4; ++g4) {
          u32x2 o1 = *(const u32x2*)(yrow + 32 * d + 8 * g4 + 4 * h);
          float a0 = bflo(o1.x) - O[d][4 * g4] * f, a1 = bfhi(o1.x) - O[d][4 * g4 + 1] * f;
          float a2 = bflo(o1.y) - O[d][4 * g4 + 2] * f, a3 = bfhi(o1.y) - O[d][4 * g4 + 3] * f;
          O[d][4 * g4] = a0; O[d][4 * g4 + 1] = a1; O[d][4 * g4 + 2] = a2; O[d][4 * g4 + 3] = a3;
          ss += a0 * a0 + a1 * a1 + a2 * a2 + a3 * a3;
        }
      ss += __shfl_xor(ss, 32);
      float rs = rsqrtf(ss * (1.f / 128.f) + EPS) * 0.8f;
#pragma unroll
      for (int d = 0; d < 4; ++d)
#pragma unroll
        for (int g4 = 0; g4 < 4; ++g4) {
          int dd = 32 * d + 8 * g4 + 4 * h;
          float4 sw = *(const float4*)(p.att_subln + dd);
          u32x2 o;
          o.x = pack2(O[d][4 * g4] * rs * sw.x, O[d][4 * g4 + 1] * rs * sw.y);
          o.y = pack2(O[d][4 * g4 + 2] * rs * sw.z, O[d][4 * g4 + 3] * rs * sw.w);
          *(u32x2*)(yrow + dd) = o;
        }
    } else {
      int b, hh, uu, s1 = 0, n1 = 0, rlo = 0, r0w = 0, rq = 0, qc = 0;
      bool na = false;
      if (item < N_A + N_B) {
        int it = item - N_A;
        b = it >> 9; hh = (it >> 6) & 7;
        int rp = it & 63;
        rq = rp * 2 + (wave >> 1);
        int half = wave & 1;
        uu = CTX + rq * 64 + half * 32;
        rlo = min(max(rp * 2 - 4, 0), 120);
        int rhi = min(max(rp * 2 + 1 - 4, 0), 120);
        r0w = min(max(rq - 4, 0), 120);
        s1 = CTX + rlo * 64;
        n1 = rhi - rlo + 8;
        qc = half * 32 + r;
        na = true;
        __syncthreads();
        for (int i = tid; i < 15 * 31; i += 256) rpb_lds[i] = p.att_rpb[hh * 15 * 31 + i];
      } else {
        int it = item - N_A - N_B - N_D;
        b = it >> 4; hh = (it >> 1) & 7;
        uu = (it & 1) * 128 + wave * 32;
      }
      f32x16 O[2];
      float l;
      attn_job<64>(QK, (size_t)b * UB + uu, hh * 64, 512 + hh * 64, (size_t)b * UB, VT + ((size_t)b * 1024 + hh * 64) * UB, 0,
                   CTX / 64, s1, n1, na, rlo, r0w, rq, qc, rpb_lds, smem, O, l);
      float inv = 1.f / l;
      u16* yrow = Y + ((size_t)b * UB + uu + r) * 1024 + hh * 64;
#pragma unroll
      for (int d = 0; d < 2; ++d)
#pragma unroll
        for (int g4 = 0; g4 < 4; ++g4) {
          int dd = 32 * d + 8 * g4 + 4 * h;
          u32x2 o;
          o.x = pack2(O[d][4 * g4] * inv, O[d][4 * g4 + 1] * inv);
          o.y = pack2(O[d][4 * g4 + 2] * inv, O[d][4 * g4 + 3] * inv);
          *(u32x2*)(yrow + dd) = o;
        }
    }
  }
}

constexpr int CP = 136;
constexpr int TP = 40;
DI bf16x8 ld_perm(const u16* rowp, int off) {
  u32x2 lo = *(const u32x2*)(rowp + off);
  u32x2 hi = *(const u32x2*)(rowp + off + 8);
  u32x4 u = {lo.x, lo.y, hi.x, hi.y};
  return __builtin_bit_cast(bf16x8, u);
}
DI bf16x8 pack8(const f32x16& x, int s2) {
  u32x4 u;
  u.x = pack2(x[8 * s2], x[8 * s2 + 1]);
  u.y = pack2(x[8 * s2 + 2], x[8 * s2 + 3]);
  u.z = pack2(x[8 * s2 + 4], x[8 * s2 + 5]);
  u.w = pack2(x[8 * s2 + 6], x[8 * s2 + 7]);
  return __builtin_bit_cast(bf16x8, u);
}

DI float ld_dev(const float* p) { return __hip_atomic_load(p, __ATOMIC_RELAXED, __HIP_MEMORY_SCOPE_AGENT); }
DI void st_dev(float* p, float v) { __hip_atomic_store(p, v, __ATOMIC_RELAXED, __HIP_MEMORY_SCOPE_AGENT); }
DI float4 ld_dev4(const float* p) {
  const unsigned long long* q = (const unsigned long long*)p;
  const unsigned long long a = __hip_atomic_load(q, __ATOMIC_RELAXED, __HIP_MEMORY_SCOPE_AGENT);
  const unsigned long long b = __hip_atomic_load(q + 1, __ATOMIC_RELAXED, __HIP_MEMORY_SCOPE_AGENT);
  return make_float4(__uint_as_float((unsigned)a), __uint_as_float((unsigned)(a >> 32)), __uint_as_float((unsigned)b),
                     __uint_as_float((unsigned)(b >> 32)));
}
DI void st_dev4(float* p, float4 v) {
  unsigned long long* q = (unsigned long long*)p;
  __hip_atomic_store(q, (unsigned long long)__float_as_uint(v.x) | ((unsigned long long)__float_as_uint(v.y) << 32), __ATOMIC_RELAXED,
                     __HIP_MEMORY_SCOPE_AGENT);
  __hip_atomic_store(q + 1, (unsigned long long)__float_as_uint(v.z) | ((unsigned long long)__float_as_uint(v.w) << 32), __ATOMIC_RELAXED,
                     __HIP_MEMORY_SCOPE_AGENT);
}
DI bf16x8 ld_perm_dev(const u16* rowp, int off) {
  const unsigned long long* q = (const unsigned long long*)(rowp + off);
  const unsigned long long a = __hip_atomic_load(q, __ATOMIC_RELAXED, __HIP_MEMORY_SCOPE_AGENT);
  const unsigned long long b = __hip_atomic_load(q + 2, __ATOMIC_RELAXED, __HIP_MEMORY_SCOPE_AGENT);
  u32x4 u = {(unsigned)a, (unsigned)(a >> 32), (unsigned)b, (unsigned)(b >> 32)};
  return __builtin_bit_cast(bf16x8, u);
}
DI void scan_gdn_seg(const Params& p, char* smem, int chain, int seg, int mode) {
  const u16* PROJ = (const u16*)(p.ws + OFF_BIG);
  const float* DAB = (const float*)(p.ws + OFF_DAB);
  const int dir = chain & 1, hd = (chain >> 1) & 3, b = chain >> 3;
  u16* OUT = (u16*)(p.ws + (dir ? OFF_OB : OFF_H));
  u16* Qb = (u16*)smem;
  u16* Kb = Qb + 32 * CP;
  u16* KTT = Kb + 32 * CP;
  u16* VT = KTT + 128 * TP;
  float* VB = (float*)(VT + 128 * TP);
  float* AM = VB + 32 * 128;
  u16* AQK = (u16*)(AM + 32 * 36);
  float* SC = (float*)(AQK + 32 * TP);
  float* cwl = SC + 128;
  int tid0 = threadIdx.x;
  asm volatile("" : "+v"(tid0));
  int tid = tid0, lane = tid & 63, wave = tid >> 6, r = lane & 31, h = lane >> 5;
  int ti = tid >> 3, sj = tid & 7;
  __syncthreads();
  for (int i = tid; i < 1152; i += 256) {
    int tap = i / 384, c = i - tap * 384;
    cwl[i] = p.rec_conv_w[tap * 1536 + (c >> 7) * 512 + hd * 128 + (c & 127)];
  }
  f32x16 S[4];
#pragma unroll
  for (int d = 0; d < 4; ++d) S[d] = zero16();
  float* GS = (float*)(p.ws + OFF_GS);
  u16* GP = (u16*)(p.ws + OFF_GP);
  if (mode == 1) {
#pragma unroll
    for (int d = 0; d < 4; ++d)
#pragma unroll
      for (int i = 0; i < 16; ++i) S[d][i] = (32 * d + crow(i, h) == 32 * wave + r) ? 1.f : 0.f;
  } else if (mode == 2 && seg > 0) {
    const float* src = GS + (size_t)(chain * NHO_G + seg - 1) * 16384 + (32 * wave + r) * 128 + 4 * h;
#pragma unroll
    for (int d = 0; d < 4; ++d)
#pragma unroll
      for (int g4 = 0; g4 < 4; ++g4) {
        const float4 v = ld_dev4(src + 32 * d + 8 * g4);
        S[d][4 * g4] = v.x; S[d][4 * g4 + 1] = v.y; S[d][4 * g4 + 2] = v.z; S[d][4 * g4 + 3] = v.w;
      }
  }
  const float vb_scale = (mode == 1) ? 0.f : 1.f;
  unsigned pf0 = 0u, pf1 = 0u, pfsink = 0u;
  const bool with_out = mode == 2;
  __syncthreads();
  for (int blk = seg * SEGC_G; blk < seg * SEGC_G + SEGC_G; ++blk) {
    tid = tid0;
    asm volatile("" : "+v"(tid));
    lane = tid & 63; wave = __builtin_amdgcn_readfirstlane(tid >> 6); r = lane & 31; h = lane >> 5; ti = tid >> 3; sj = tid & 7;
    const bool isctx = blk < 8;
    const int seg_base = isctx ? 0 : CTX, seg_len = isctx ? CTX : SEQ;
    const int bi = isctx ? blk : blk - 8;
    {
      const int sidx = bi * 32 + ti;
      const int pos = dir ? seg_len - 1 - sidx : sidx;
      const size_t row = (size_t)b * UB + seg_base + pos;
      const u16* pr = PROJ + row * NPROJ;
      const float mp = pos > 0 ? 1.f : 0.f, mn = pos < seg_len - 1 ? 1.f : 0.f;
      const float g = DAB[row * 16 + dir * 4 + hd], beta = DAB[row * 16 + 8 + dir * 4 + hd];
      const float betav = beta * vb_scale;
      if (sj == 0) SC[ti * 4] = g;
#pragma unroll
      for (int pp = 0; pp < 3; ++pp) {
        const int part = (pp + 2) % 3;
        if (part == 0 && !with_out) continue;
        if (part == 2 && mode == 1) {
#pragma unroll
          for (int k = 0; k < 4; ++k) *(float4*)(VB + ti * 128 + sj * 16 + 4 * k) = make_float4(0.f, 0.f, 0.f, 0.f);
          continue;
        }
        float val[16];
        const u16* pc = pr + 2560 + part * 512 + hd * 128 + sj * 16;
        const float* cw = cwl + part * 128 + sj * 16;
#pragma unroll
        for (int half = 0; half < 2; ++half) {
          u32x4 x0 = *(const u32x4*)(pc - NPROJ + half * 8);
          u32x4 x1 = *(const u32x4*)(pc + half * 8);
          u32x4 x2 = *(const u32x4*)(pc + NPROJ + half * 8);
          unsigned a0[4] = {x0.x, x0.y, x0.z, x0.w}, a1[4] = {x1.x, x1.y, x1.z, x1.w}, a2[4] = {x2.x, x2.y, x2.z, x2.w};
#pragma unroll
          for (int k = 0; k < 4; ++k) {
            int c0 = half * 8 + 2 * k;
            float y0 = cw[c0] * mp * bflo(a0[k]) + cw[384 + c0] * bflo(a1[k]) + cw[768 + c0] * mn * bflo(a2[k]);
            float y1 = cw[c0 + 1] * mp * bfhi(a0[k]) + cw[384 + c0 + 1] * bfhi(a1[k]) + cw[768 + c0 + 1] * mn * bfhi(a2[k]);
            val[c0] = siluf_(y0);
            val[c0 + 1] = siluf_(y1);
          }
          __builtin_amdgcn_sched_barrier(0);
        }
        if (part == 2) {
#pragma unroll
          for (int k = 0; k < 4; ++k)
            *(float4*)(VB + ti * 128 + sj * 16 + 4 * k) =
                make_float4(betav * val[4 * k], betav * val[4 * k + 1], betav * val[4 * k + 2], betav * val[4 * k + 3]);
        } else {
          float ss = 0.f;
#pragma unroll
          for (int k = 0; k < 16; ++k) ss += val[k] * val[k];
          ss = dpp_sum8(ss);
          const float rn = rsqrtf(ss + EPS) * (part == 0 ? 0.08838834764831845f : 1.f);
          u16* dstp = (part == 0 ? Qb : Kb) + ti * CP + sj * 16;
#pragma unroll
          for (int hh = 0; hh < 2; ++hh) {
            u32x4 o;
            o.x = pack2(val[8 * hh] * rn, val[8 * hh + 1] * rn); o.y = pack2(val[8 * hh + 2] * rn, val[8 * hh + 3] * rn);
            o.z = pack2(val[8 * hh + 4] * rn, val[8 * hh + 5] * rn); o.w = pack2(val[8 * hh + 6] * rn, val[8 * hh + 7] * rn);
            *(u32x4*)(dstp + 8 * hh) = o;
          }
        }
        __builtin_amdgcn_sched_barrier(0);
      }
      __syncthreads();
      float G = 0.f, Gl = 0.f;
      for (int t = 0; t < 32; ++t) {
        float gt = SC[t * 4];
        Gl += gt;
        G += (t <= ti) ? gt : 0.f;
      }
      const float eG = __expf(G), eT = __expf(Gl - G);
      __syncthreads();
      if (sj == 0) *(float4*)(SC + ti * 4) = make_float4(G, beta, eG, eT);
      if (tid == 0) AM[35] = __expf(Gl);
      {
        const u32x4 k0 = *(const u32x4*)(Kb + ti * CP + sj * 16), k1 = *(const u32x4*)(Kb + ti * CP + sj * 16 + 8);
        const unsigned kk[8] = {k0.x, k0.y, k0.z, k0.w, k1.x, k1.y, k1.z, k1.w};
#pragma unroll
        for (int k = 0; k < 8; ++k) {
          KTT[(sj * 16 + 2 * k) * TP + ti] = f2bf(bflo(kk[k]) * eT);
          KTT[(sj * 16 + 2 * k + 1) * TP + ti] = f2bf(bfhi(kk[k]) * eT);
        }
      }
    }
    __syncthreads();
    f32x16 KS = zero16();
#pragma unroll
    for (int d = 0; d < 4; ++d)
#pragma unroll
      for (int s2 = 0; s2 < 2; ++s2) {
        const bf16x8 sp = pack8(S[d], s2);
        KS = MFMA32(ld_perm(Kb + r * CP, 32 * d + 16 * s2 + 4 * h), sp, KS);
        __builtin_amdgcn_sched_barrier(0);
      }
    if (wave == 0 || (wave == 1 && with_out)) {
      f32x16 X = zero16();
      const u16* ap = (wave == 0 ? Kb : Qb) + r * CP + 8 * h;
      const u16* bp = Kb + r * CP + 8 * h;
#pragma unroll
      for (int ks = 0; ks < 8; ++ks) X = MFMA32(*(const bf16x8*)(ap + 16 * ks), *(const bf16x8*)(bp + 16 * ks), X);
      const float Gs = SC[r * 4];
#pragma unroll
      for (int i = 0; i < 16; ++i) {
        const int c = crow(i, h);
        const float4 sc = *(const float4*)(SC + c * 4);
        const float gam = __expf(fminf(sc.x - Gs, 0.f));
        if (wave == 0) AM[c * 36 + r] = (r < c) ? sc.y * X[i] * gam : 0.f;
        else AQK[c * TP + r] = f2bf((r <= c) ? X[i] * gam : 0.f);
      }
    }
#pragma unroll
    for (int i = 0; i < 16; ++i) {
      const int t = crow(i, h);
      const float4 sc = *(const float4*)(SC + t * 4);
      float* vb = VB + t * 128 + 32 * wave + r;
      *vb = *vb - sc.y * sc.z * KS[i];
    }
    __syncthreads();
    if (tid >= 128) {
      pfsink ^= pf0 ^ pf1;
      pf0 = 0u; pf1 = 0u;
      const int nb = blk + 1;
      if (nb < seg * SEGC_G + SEGC_G) {
        const bool nctx = nb < 8;
        const int nbase = nctx ? 0 : CTX, nlen = nctx ? CTX : SEQ, nbi = nctx ? nb : nb - 8;
        const int rlo = (dir ? nlen - 32 - nbi * 32 : nbi * 32) - 1;
        const u16* pbase = PROJ + ((size_t)b * UB + nbase + rlo) * NPROJ + 2560 + hd * 128;
        const int l0 = tid - 128, l1 = tid;
        pf0 = *(const unsigned*)(pbase + (size_t)(l0 / 6) * NPROJ + ((l0 % 6) >> 1) * 512 + ((l0 % 6) & 1) * 64);
        if (l1 < 204) pf1 = *(const unsigned*)(pbase + (size_t)(l1 / 6) * NPROJ + ((l1 % 6) >> 1) * 512 + ((l1 % 6) & 1) * 64);
        else if (l1 < 220)
          pf1 = __float_as_uint(DAB[((size_t)b * UB + nbase + rlo + 1) * 16 + (l1 - 204) * 32]);
      }
    }
    if (tid < 128) {
      float x[16];
#pragma unroll
      for (int c = 0; c < 16; ++c) {
        float acc = VB[c * 128 + tid];
#pragma unroll
        for (int s4 = 0; s4 < (c + 3) / 4; ++s4) {
          const float4 a4 = *(const float4*)(AM + c * 36 + 4 * s4);
          if (4 * s4 < c) acc -= a4.x * x[4 * s4];
          if (4 * s4 + 1 < c) acc -= a4.y * x[4 * s4 + 1];
          if (4 * s4 + 2 < c) acc -= a4.z * x[4 * s4 + 2];
          if (4 * s4 + 3 < c) acc -= a4.w * x[4 * s4 + 3];
        }
        x[c] = acc;
        __builtin_amdgcn_sched_barrier(0);
      }
#pragma unroll
      for (int q4 = 0; q4 < 2; ++q4) {
        u32x4 u;
        u.x = pack2(x[8 * q4], x[8 * q4 + 1]); u.y = pack2(x[8 * q4 + 2], x[8 * q4 + 3]);
        u.z = pack2(x[8 * q4 + 4], x[8 * q4 + 5]); u.w = pack2(x[8 * q4 + 6], x[8 * q4 + 7]);
        *(u32x4*)(VT + tid * TP + 8 * q4) = u;
      }
#pragma unroll
      for (int c = 16; c < 32; ++c) {
        float acc = VB[c * 128 + tid];
#pragma unroll
        for (int s4 = 0; s4 < 4; ++s4) {
          const float4 a4 = *(const float4*)(AM + c * 36 + 4 * s4);
          acc -= a4.x * x[4 * s4] + a4.y * x[4 * s4 + 1] + a4.z * x[4 * s4 + 2] + a4.w * x[4 * s4 + 3];
        }
        VB[c * 128 + tid] = acc;
        __builtin_amdgcn_sched_barrier(0);
      }
#pragma unroll
      for (int c = 16; c < 32; ++c) {
        float acc = VB[c * 128 + tid];
#pragma unroll
        for (int s4 = 4; s4 < (c + 3) / 4; ++s4) {
          const float4 a4 = *(const float4*)(AM + c * 36 + 4 * s4);
          if (4 * s4 < c) acc -= a4.x * x[4 * s4 - 16];
          if (4 * s4 + 1 < c) acc -= a4.y * x[4 * s4 + 1 - 16];
          if (4 * s4 + 2 < c) acc -= a4.z * x[4 * s4 + 2 - 16];
          if (4 * s4 + 3 < c) acc -= a4.w * x[4 * s4 + 3 - 16];
        }
        x[c - 16] = acc;
        __builtin_amdgcn_sched_barrier(0);
      }
#pragma unroll
      for (int q4 = 0; q4 < 2; ++q4) {
        u32x4 u;
        u.x = pack2(x[8 * q4], x[8 * q4 + 1]); u.y = pack2(x[8 * q4 + 2], x[8 * q4 + 3]);
        u.z = pack2(x[8 * q4 + 4], x[8 * q4 + 5]); u.w = pack2(x[8 * q4 + 6], x[8 * q4 + 7]);
        *(u32x4*)(VT + tid * TP + 16 + 8 * q4) = u;
      }
    }
    __syncthreads();
    {
      const bf16x8 vf0 = *(const bf16x8*)(VT + (32 * wave + r) * TP + 8 * h);
      const bf16x8 vf1 = *(const bf16x8*)(VT + (32 * wave + r) * TP + 16 + 8 * h);
      if (with_out && !isctx) {
        f32x16 QS = zero16();
#pragma unroll
        for (int d = 0; d < 4; ++d)
#pragma unroll
          for (int s2 = 0; s2 < 2; ++s2)
            QS = MFMA32(ld_perm(Qb + r * CP, 32 * d + 16 * s2 + 4 * h), pack8(S[d], s2), QS);
#pragma unroll
        for (int i = 0; i < 16; ++i) QS[i] *= SC[crow(i, h) * 4 + 2];
        QS = MFMA32(*(const bf16x8*)(AQK + r * TP + 8 * h), vf0, QS);
        QS = MFMA32(*(const bf16x8*)(AQK + r * TP + 16 + 8 * h), vf1, QS);
        const int pos0 = dir ? seg_len - 1 - bi * 32 : bi * 32;
        u16* op = OUT + ((size_t)b * UB + seg_base + pos0) * 1024 + 512 + hd * 128 + 32 * wave + r;
        int ostep = dir ? -1024 : 1024;
        asm volatile("" : "+s"(ostep));
#pragma unroll
        for (int i = 0; i < 16; ++i) op[crow(i, h) * ostep] = f2bf(QS[i]);
      }
      const float dec = AM[35];
#pragma unroll
      for (int d = 0; d < 4; ++d) {
#pragma unroll
        for (int i = 0; i < 16; ++i) S[d][i] *= dec;
        S[d] = MFMA32(*(const bf16x8*)(KTT + (32 * d + r) * TP + 8 * h), vf0, S[d]);
        S[d] = MFMA32(*(const bf16x8*)(KTT + (32 * d + r) * TP + 16 + 8 * h), vf1, S[d]);
      }
    }
    __syncthreads();
  }
  if (tid >= 128) ((unsigned*)(p.ws + OFF_BAR))[1 + (tid & 63)] = pfsink ^ pf0 ^ pf1;
  if (mode == 0) {
    float* dst = GS + (size_t)(chain * NHO_G + seg) * 16384 + (32 * wave + r) * 128 + 4 * h;
#pragma unroll
    for (int d = 0; d < 4; ++d)
#pragma unroll
      for (int g4 = 0; g4 < 4; ++g4)
        st_dev4(dst + 32 * d + 8 * g4, make_float4(S[d][4 * g4], S[d][4 * g4 + 1], S[d][4 * g4 + 2], S[d][4 * g4 + 3]));
  } else if (mode == 1) {
    u16* dst = GP + (size_t)(chain * NHO_G + seg) * 16384 + 32 * wave + r;
#pragma unroll
    for (int d = 0; d < 4; ++d)
#pragma unroll
      for (int i = 0; i < 16; ++i) __hip_atomic_store(dst + (32 * d + crow(i, h)) * 128, f2bf(S[d][i]), __ATOMIC_RELAXED, __HIP_MEMORY_SCOPE_AGENT);
  }
}

DI void scan_hgrn_seg(const Params& p, char* smem, int chain, int seg, int mode) {
  const u16* PROJ = (const u16*)(p.ws + OFF_BIG);
  const float* misc = (const float*)(p.ws + OFF_MISC);
  const int dir = chain & 1, hd = (chain >> 1) & 3, b = chain >> 3;
  u16* OUT = (u16*)(p.ws + (dir ? OFF_OB : OFF_H));
  u16* QG = (u16*)smem;
  u16* QP = QG + 32 * CP;
  u16* KT = QP + 32 * CP;
  u16* KTT = KT + 32 * CP;
  u16* VT = KTT + 128 * TP;
  u16* AQK = VT + 128 * TP;
  float* LG = (float*)(AQK + 32 * TP);
  float* GL = LG + 32 * 128;
  float* lbs = GL + 128;
  int tid0 = threadIdx.x;
  asm volatile("" : "+v"(tid0));
  int tid = tid0, lane = tid & 63, wave = tid >> 6, r = lane & 31, h = lane >> 5;
  int ti = tid >> 3, sj = tid & 7;
  __syncthreads();
  if (tid < 128) lbs[tid] = misc[16 + dir * 512 + hd * 128 + tid];
  f32x16 S[4];
#pragma unroll
  for (int d = 0; d < 4; ++d) S[d] = zero16();
  float* HS = (float*)(p.ws + OFF_HS);
  float* HD = (float*)(p.ws + OFF_HD);
  if (mode == 2 && seg > 0) {
    const float* src = HS + (size_t)(chain * NHO_H + seg - 1) * 16384 + (32 * wave + r) * 128 + 4 * h;
#pragma unroll
    for (int d = 0; d < 4; ++d)
#pragma unroll
      for (int g4 = 0; g4 < 4; ++g4) {
        const float4 v = ld_dev4(src + 32 * d + 8 * g4);
        S[d][4 * g4] = v.x; S[d][4 * g4 + 1] = v.y; S[d][4 * g4 + 2] = v.z; S[d][4 * g4 + 3] = v.w;
      }
  }
  const bool with_out = mode == 2;
  float dsum = 0.f;
  __syncthreads();
  for (int blk = seg * SEGC_H; blk < seg * SEGC_H + SEGC_H; ++blk) {
    tid = tid0;
    asm volatile("" : "+v"(tid));
    lane = tid & 63; wave = __builtin_amdgcn_readfirstlane(tid >> 6); r = lane & 31; h = lane >> 5; ti = tid >> 3; sj = tid & 7;
    const bool isctx = blk < 8;
    const int seg_base = isctx ? 0 : CTX, seg_len = isctx ? CTX : SEQ;
    const int bi = isctx ? blk : blk - 8;
    {
      const int sidx = bi * 32 + ti;
      const int pos = dir ? seg_len - 1 - sidx : sidx;
      const size_t row = (size_t)b * UB + seg_base + pos;
      const u16* pr = PROJ + row * NPROJ;
      const u16* pq = pr + hd * 128 + sj * 16;
      const u16* pf = pr + (dir ? 1024 : 512) + hd * 128 + sj * 16;
      const u16* pv = pr + 1536 + hd * 128 + sj * 16;
      u32x4 q0 = *(const u32x4*)pq, q1 = *(const u32x4*)(pq + 8);
      u32x4 f0 = *(const u32x4*)pf, f1 = *(const u32x4*)(pf + 8);
      u32x4 v0 = *(const u32x4*)pv, v1 = *(const u32x4*)(pv + 8);
      unsigned qa[8] = {q0.x, q0.y, q0.z, q0.w, q1.x, q1.y, q1.z, q1.w};
      unsigned fa[8] = {f0.x, f0.y, f0.z, f0.w, f1.x, f1.y, f1.z, f1.w};
      unsigned va[8] = {v0.x, v0.y, v0.z, v0.w, v1.x, v1.y, v1.z, v1.w};
      float qv[16], kv[16];
#pragma unroll
      for (int k = 0; k < 8; ++k) {
        const float l0 = lbs[sj * 16 + 2 * k], l1 = lbs[sj * 16 + 2 * k + 1];
        qv[2 * k] = siluf_(bflo(qa[k])) * 0.08838834764831845f;
        qv[2 * k + 1] = siluf_(bfhi(qa[k])) * 0.08838834764831845f;
        const float fa0 = l0 + (1.f - l0) * sigmoidf_(bflo(fa[k]));
        const float fa1 = l1 + (1.f - l1) * sigmoidf_(bfhi(fa[k]));
        kv[2 * k] = 1.f - fa0;
        kv[2 * k + 1] = 1.f - fa1;
        LG[ti * 128 + sj * 16 + 2 * k] = __logf(fa0);
        LG[ti * 128 + sj * 16 + 2 * k + 1] = __logf(fa1);
        VT[(sj * 16 + 2 * k) * TP + ti] = (u16)(va[k] & 0xffffu);
        VT[(sj * 16 + 2 * k + 1) * TP + ti] = (u16)(va[k] >> 16);
      }
      __syncthreads();
      if (tid < 128) {
        float cv[32];
#pragma unroll
        for (int t = 0; t < 32; ++t) cv[t] = LG[t * 128 + tid];
        float acc = 0.f;
#pragma unroll
        for (int t = 0; t < 32; ++t) {
          acc += cv[t];
          LG[t * 128 + tid] = acc;
        }
        GL[tid] = __expf(acc);
        dsum += acc;
      }
      __syncthreads();
      u32x4 o0[2], o1[2], o2[2];
      unsigned w0[8], w1[8], w2[8];
#pragma unroll
      for (int k = 0; k < 8; ++k) {
        const int d0 = sj * 16 + 2 * k;
        const float G0 = LG[ti * 128 + d0], G1 = LG[ti * 128 + d0 + 1];
        const float L0 = LG[31 * 128 + d0], L1 = LG[31 * 128 + d0 + 1];
        const float kt0 = kv[2 * k] * __expf(L0 - G0), kt1 = kv[2 * k + 1] * __expf(L1 - G1);
        w0[k] = pack2(qv[2 * k] * __expf(G0), qv[2 * k + 1] * __expf(G1));
        w1[k] = pack2(qv[2 * k] * __expf(G0 - L0), qv[2 * k + 1] * __expf(G1 - L1));
        w2[k] = pack2(kt0, kt1);
        KTT[d0 * TP + ti] = (u16)(w2[k] & 0xffffu);
        KTT[(d0 + 1) * TP + ti] = (u16)(w2[k] >> 16);
      }
#pragma unroll
      for (int hh = 0; hh < 2; ++hh) {
        o0[hh] = (u32x4){w0[4 * hh], w0[4 * hh + 1], w0[4 * hh + 2], w0[4 * hh + 3]};
        o1[hh] = (u32x4){w1[4 * hh], w1[4 * hh + 1], w1[4 * hh + 2], w1[4 * hh + 3]};
        o2[hh] = (u32x4){w2[4 * hh], w2[4 * hh + 1], w2[4 * hh + 2], w2[4 * hh + 3]};
        *(u32x4*)(QG + ti * CP + sj * 16 + 8 * hh) = o0[hh];
        *(u32x4*)(QP + ti * CP + sj * 16 + 8 * hh) = o1[hh];
        *(u32x4*)(KT + ti * CP + sj * 16 + 8 * hh) = o2[hh];
      }
    }
    __syncthreads();
    f32x16 QS = zero16();
    if (with_out && !isctx) {
#pragma unroll
      for (int d = 0; d < 4; ++d)
#pragma unroll
        for (int s2 = 0; s2 < 2; ++s2)
          QS = MFMA32(ld_perm(QG + r * CP, 32 * d + 16 * s2 + 4 * h), pack8(S[d], s2), QS);
      if (wave == 0) {
        f32x16 X = zero16();
#pragma unroll
        for (int ks = 0; ks < 8; ++ks)
          X = MFMA32(*(const bf16x8*)(QP + r * CP + 16 * ks + 8 * h), *(const bf16x8*)(KT + r * CP + 16 * ks + 8 * h), X);
#pragma unroll
        for (int i = 0; i < 16; ++i) {
          const int c = crow(i, h);
          AQK[c * TP + r] = f2bf((r <= c) ? X[i] : 0.f);
        }
      }
    }
    __syncthreads();
    {
      const bf16x8 vf0 = *(const bf16x8*)(VT + (32 * wave + r) * TP + 8 * h);
      const bf16x8 vf1 = *(const bf16x8*)(VT + (32 * wave + r) * TP + 16 + 8 * h);
      if (with_out && !isctx) {
        QS = MFMA32(*(const bf16x8*)(AQK + r * TP + 8 * h), vf0, QS);
        QS = MFMA32(*(const bf16x8*)(AQK + r * TP + 16 + 8 * h), vf1, QS);
        const int pos0 = dir ? seg_len - 1 - bi * 32 : bi * 32;
        u16* op = OUT + ((size_t)b * UB + seg_base + pos0) * 1024 + hd * 128 + 32 * wave + r;
        int ostep = dir ? -1024 : 1024;
        asm volatile("" : "+s"(ostep));
#pragma unroll
        for (int i = 0; i < 16; ++i) op[crow(i, h) * ostep] = f2bf(QS[i]);
      }
#pragma unroll
      for (int d = 0; d < 4; ++d) {
#pragma unroll
        for (int i = 0; i < 16; ++i) S[d][i] *= GL[32 * d + crow(i, h)];
        S[d] = MFMA32(*(const bf16x8*)(KTT + (32 * d + r) * TP + 8 * h), vf0, S[d]);
        S[d] = MFMA32(*(const bf16x8*)(KTT + (32 * d + r) * TP + 16 + 8 * h), vf1, S[d]);
      }
    }
    __syncthreads();
  }
  if (mode == 0) {
    float* dst = HS + (size_t)(chain * NHO_H + seg) * 16384 + (32 * wave + r) * 128 + 4 * h;
#pragma unroll
    for (int d = 0; d < 4; ++d)
#pragma unroll
      for (int g4 = 0; g4 < 4; ++g4)
        st_dev4(dst + 32 * d + 8 * g4, make_float4(S[d][4 * g4], S[d][4 * g4 + 1], S[d][4 * g4 + 2], S[d][4 * g4 + 3]));
    if (tid < 128) st_dev(HD + (chain * NHO_H + seg) * 128 + tid, __expf(dsum));
  }
}

DI void combine_gdn(const Params& p, int chain) {
  float* GS = (float*)(p.ws + OFF_GS);
  const u16* GP = (const u16*)(p.ws + OFF_GP);
  const int lane = threadIdx.x & 63, wave = threadIdx.x >> 6, r = lane & 31, h = lane >> 5;
  f32x16 S[4], acc[4];
  {
    const float* src = GS + (size_t)(chain * NHO_G) * 16384 + (32 * wave + r) * 128 + 4 * h;
#pragma unroll
    for (int d = 0; d < 4; ++d)
#pragma unroll
      for (int g4 = 0; g4 < 4; ++g4) {
        const float4 v = ld_dev4(src + 32 * d + 8 * g4);
        S[d][4 * g4] = v.x; S[d][4 * g4 + 1] = v.y; S[d][4 * g4 + 2] = v.z; S[d][4 * g4 + 3] = v.w;
      }
  }
#pragma unroll 1
  for (int j = 1; j < NHO_G; ++j) {
    float* loc = GS + (size_t)(chain * NHO_G + j) * 16384 + (32 * wave + r) * 128 + 4 * h;
    const u16* P = GP + (size_t)(chain * NHO_G + j) * 16384;
#pragma unroll
    for (int d = 0; d < 4; ++d)
#pragma unroll
      for (int g4 = 0; g4 < 4; ++g4) {
        const float4 v = ld_dev4(loc + 32 * d + 8 * g4);
        acc[d][4 * g4] = v.x; acc[d][4 * g4 + 1] = v.y; acc[d][4 * g4 + 2] = v.z; acc[d][4 * g4 + 3] = v.w;
      }
#pragma unroll
    for (int d2 = 0; d2 < 4; ++d2)
#pragma unroll
      for (int s2 = 0; s2 < 2; ++s2) {
        const bf16x8 sp = pack8(S[d2], s2);
#pragma unroll
        for (int d = 0; d < 4; ++d) acc[d] = MFMA32(ld_perm_dev(P + (32 * d + r) * 128, 32 * d2 + 16 * s2 + 4 * h), sp, acc[d]);
        __builtin_amdgcn_sched_barrier(0);
      }
#pragma unroll
    for (int d = 0; d < 4; ++d) {
      S[d] = acc[d];
#pragma unroll
      for (int g4 = 0; g4 < 4; ++g4)
        st_dev4(loc + 32 * d + 8 * g4, make_float4(S[d][4 * g4], S[d][4 * g4 + 1], S[d][4 * g4 + 2], S[d][4 * g4 + 3]));
    }
  }
}
DI void combine_hgrn(const Params& p, int chain) {
  float* HS = (float*)(p.ws + OFF_HS);
  const float* HD = (const float*)(p.ws + OFF_HD);
  const int lane = threadIdx.x & 63, wave = threadIdx.x >> 6, r = lane & 31, h = lane >> 5;
  float4 S[16];
  {
    const float* src = HS + (size_t)(chain * NHO_H) * 16384 + (32 * wave + r) * 128 + 4 * h;
#pragma unroll
    for (int q = 0; q < 16; ++q) S[q] = ld_dev4(src + 8 * q);
  }
#pragma unroll 1
  for (int j = 1; j < NHO_H; ++j) {
    float* loc = HS + (size_t)(chain * NHO_H + j) * 16384 + (32 * wave + r) * 128 + 4 * h;
    const float* D = HD + (chain * NHO_H + j) * 128 + 4 * h;
#pragma unroll
    for (int q = 0; q < 16; ++q) {
      const float4 l = ld_dev4(loc + 8 * q), dd = ld_dev4(D + 8 * q);
      S[q] = make_float4(dd.x * S[q].x + l.x, dd.y * S[q].y + l.y, dd.z * S[q].z + l.z, dd.w * S[q].w + l.w);
      st_dev4(loc + 8 * q, S[q]);
      if ((q & 3) == 3) __builtin_amdgcn_sched_barrier(0);
    }
  }
}

DI void phase_scan(const Params& p, char* smem, const XcdBarrier& xb) {
  for (int item = blockIdx.x; item < 32 * NHO_G * 2 + 32 * NHO_H; item += gridDim.x) {
    if (item < 32 * NHO_G * 2) {
      const int rest = item >> 5;
      scan_gdn_seg(p, smem, item & 31, rest >> 1, rest & 1);
    } else {
      const int k = item - 32 * NHO_G * 2;
      scan_hgrn_seg(p, smem, k & 31, k >> 5, 0);
    }
  }
  xcd_barrier(xb);
  for (int item = blockIdx.x; item < 64; item += gridDim.x) {
    if (item < 32) combine_gdn(p, item);
    else combine_hgrn(p, item - 32);
  }
  xcd_barrier(xb);
  for (int item = blockIdx.x; item < 32 * NSEG_H + 32 * NSEG_G; item += gridDim.x) {
    if (item < 32 * NSEG_H) scan_hgrn_seg(p, smem, item & 31, item >> 5, 2);
    else scan_gdn_seg(p, smem, item & 31, (item - 32 * NSEG_H) >> 5, 2);
  }
}

DI void phase_merge(const Params& p) {
  const u16* PROJ = (const u16*)(p.ws + OFF_BIG);
  u16* H = (u16*)(p.ws + OFF_H);
  const u16* OB = (const u16*)(p.ws + OFF_OB);
  const int lane = threadIdx.x & 63, wave = threadIdx.x >> 6;
  for (int item = blockIdx.x; item < NB * SEQ / 4; item += gridDim.x) {
    int tkn = item * 4 + wave;
    int b = tkn / SEQ, t = tkn - b * SEQ;
    size_t row = (size_t)b * UB + CTX + t;
    int c0 = lane * 16;
    int kind = c0 >> 9;
    const u16* gp = PROJ + row * NPROJ + (kind ? 4096 + (c0 - 512) : 2048 + c0);
    const float* w = (kind ? p.rec_d_norm : p.rec_c_norm) + (c0 & 127);
    u16* hp = H + row * 1024 + c0;
    const u16* bp = OB + row * 1024 + c0;
    float o[16], gt[16];
    float ss = 0.f;
#pragma unroll
    for (int half = 0; half < 2; ++half) {
      uint4 a = *(const uint4*)(hp + half * 8), bq = *(const uint4*)(bp + half * 8), g = *(const uint4*)(gp + half * 8);
      unsigned aa[4] = {a.x, a.y, a.z, a.w}, bb[4] = {bq.x, bq.y, bq.z, bq.w}, gg[4] = {g.x, g.y, g.z, g.w};
#pragma unroll
      for (int k = 0; k < 4; ++k) {
        int c = half * 8 + 2 * k;
        o[c] = bflo(aa[k]) + bflo(bb[k]);
        o[c + 1] = bfhi(aa[k]) + bfhi(bb[k]);
        gt[c] = bflo(gg[k]);
        gt[c + 1] = bfhi(gg[k]);
        ss += o[c] * o[c] + o[c + 1] * o[c + 1];
      }
    }
    ss = dpp_sum8(ss);
    float rs = rsqrtf(ss * (1.f / 128.f) + EPS);
    uint4 r0, r1;
    unsigned rr[8];
#pragma unroll
    for (int k = 0; k < 8; ++k)
      rr[k] = pack2(o[2 * k] * rs * w[2 * k] * siluf_(gt[2 * k]), o[2 * k + 1] * rs * w[2 * k + 1] * siluf_(gt[2 * k + 1]));
    r0.x = rr[0]; r0.y = rr[1]; r0.z = rr[2]; r0.w = rr[3];
    r1.x = rr[4]; r1.y = rr[5]; r1.z = rr[6]; r1.w = rr[7];
    *(uint4*)hp = r0;
    *(uint4*)(hp + 8) = r1;
  }
}

constexpr int N_PHASES = 17;
#ifndef PH_MASK
#define PH_MASK 0xFFFFFFFFu
#endif
#ifndef DUP_PH
#define DUP_PH -1
#endif
__global__ void __launch_bounds__(256, 2) hybrid_trunk_kernel(Params p) {
  __shared__ __attribute__((aligned(16))) char smem[79872];
  cg::grid_group grid = cg::this_grid();
  __shared__ uint4 xb_words;
  if (threadIdx.x == 0) xb_words = make_uint4(0u, 0u, 0u, 0u);
  __syncthreads();
  XcdBarrier xb = xcd_barrier_post((unsigned*)(p.ws + OFF_BAR), (volatile LAS unsigned*)&xb_words);
  if (p.ph_hi > 1000) grid.sync();
  if constexpr ((PH_MASK >> 0) & 1u) {
    if (p.ph_lo <= 0 && 0 < p.ph_hi) {
      if (0 > p.ph_lo) xcd_barrier(xb);
      phase_prep(p, smem);
      if constexpr (DUP_PH == 0) { grid.sync(); phase_prep(p, smem); }
    }
  }
  if constexpr ((PH_MASK >> 1) & 1u) {
    if (p.ph_lo <= 1 && 1 < p.ph_hi) {
      if (1 > p.ph_lo) xcd_barrier(xb);
      phase_norm(p, 0, 0, false);
      if constexpr (DUP_PH == 1) { grid.sync(); phase_norm(p, 0, 0, false); }
    }
  }
  if constexpr ((PH_MASK >> 2) & 1u) {
    if (p.ph_lo <= 2 && 2 < p.ph_hi) {
      if (2 > p.ph_lo) xcd_barrier(xb);
      phase_gemm_att_in(p, smem);
      if constexpr (DUP_PH == 2) { grid.sync(); phase_gemm_att_in(p, smem); }
    }
  }
  if constexpr ((PH_MASK >> 3) & 1u) {
    if (p.ph_lo <= 3 && 3 < p.ph_hi) {
      if (3 > p.ph_lo) xcd_barrier(xb);
      phase_attn(p, smem);
      if constexpr (DUP_PH == 3) { grid.sync(); phase_attn(p, smem); }
    }
  }
  if constexpr ((PH_MASK >> 4) & 1u) {
    if (p.ph_lo <= 4 && 4 < p.ph_hi) {
      if (4 > p.ph_lo) xcd_barrier(xb);
      phase_gemm_resid(p, smem, (const u16*)(p.ws + OFF_H), 1024, (const u16*)(p.ws + OFF_W_MIX), 1024, 0, 2, true, false);
      if constexpr (DUP_PH == 4) { grid.sync(); phase_gemm_resid(p, smem, (const u16*)(p.ws + OFF_H), 1024, (const u16*)(p.ws + OFF_W_MIX), 1024, 0, 2, true, false); }
    }
  }
  if constexpr ((PH_MASK >> 5) & 1u) {
    if (p.ph_lo <= 5 && 5 < p.ph_hi) {
      if (5 > p.ph_lo) xcd_barrier(xb);
      phase_norm(p, 0, 1, false);
      if constexpr (DUP_PH == 5) { grid.sync(); phase_norm(p, 0, 1, false); }
    }
  }
  if constexpr ((PH_MASK >> 6) & 1u) {
    if (p.ph_lo <= 6 && 6 < p.ph_hi) {
      if (6 > p.ph_lo) xcd_barrier(xb);
      phase_gemm_gu(p, smem, 0, false);
      if constexpr (DUP_PH == 6) { grid.sync(); phase_gemm_gu(p, smem, 0, false); }
    }
  }
  if constexpr ((PH_MASK >> 7) & 1u) {
    if (p.ph_lo <= 7 && 7 < p.ph_hi) {
      if (7 > p.ph_lo) xcd_barrier(xb);
      phase_gemm_resid(p, smem, (const u16*)(p.ws + OFF_BIG), DFF, (const u16*)(p.ws + OFF_W_DN), DFF, 0, 5, false, false);
      if constexpr (DUP_PH == 7) { grid.sync(); phase_gemm_resid(p, smem, (const u16*)(p.ws + OFF_BIG), DFF, (const u16*)(p.ws + OFF_W_DN), DFF, 0, 5, false, false); }
    }
  }
  if constexpr ((PH_MASK >> 8) & 1u) {
    if (p.ph_lo <= 8 && 8 < p.ph_hi) {
      if (8 > p.ph_lo) xcd_barrier(xb);
      phase_norm(p, 1, 2, false);
      if constexpr (DUP_PH == 8) { grid.sync(); phase_norm(p, 1, 2, false); }
    }
  }
  if constexpr ((PH_MASK >> 9) & 1u) {
    if (p.ph_lo <= 9 && 9 < p.ph_hi) {
      if (9 > p.ph_lo) xcd_barrier(xb);
      phase_gemm_rec_in(p, smem);
      if constexpr (DUP_PH == 9) { grid.sync(); phase_gemm_rec_in(p, smem); }
    }
  }
  if constexpr ((PH_MASK >> 10) & 1u) {
    if (p.ph_lo <= 10 && 10 < p.ph_hi) {
      if (10 > p.ph_lo) xcd_barrier(xb);
      phase_scan(p, smem, xb);
      if constexpr (DUP_PH == 10) { xcd_barrier(xb); phase_scan(p, smem, xb); }
    }
  }
  if constexpr ((PH_MASK >> 11) & 1u) {
    if (p.ph_lo <= 11 && 11 < p.ph_hi) {
      if (11 > p.ph_lo) xcd_barrier(xb);
      phase_merge(p);
      if constexpr (DUP_PH == 11) { grid.sync(); phase_merge(p); }
    }
  }
  if constexpr ((PH_MASK >> 12) & 1u) {
    if (p.ph_lo <= 12 && 12 < p.ph_hi) {
      if (12 > p.ph_lo) xcd_barrier(xb);
      phase_gemm_resid(p, smem, (const u16*)(p.ws + OFF_H), 1024, (const u16*)(p.ws + OFF_W_MIX) + (size_t)1024 * 1024, 1024, 1, 2, false, true);
      if constexpr (DUP_PH == 12) { grid.sync(); phase_gemm_resid(p, smem, (const u16*)(p.ws + OFF_H), 1024, (const u16*)(p.ws + OFF_W_MIX) + (size_t)1024 * 1024, 1024, 1, 2, false, true); }
    }
  }
  if constexpr ((PH_MASK >> 13) & 1u) {
    if (p.ph_lo <= 13 && 13 < p.ph_hi) {
      if (13 > p.ph_lo) xcd_barrier(xb);
      phase_norm(p, 1, 1, true);
      if constexpr (DUP_PH == 13) { grid.sync(); phase_norm(p, 1, 1, true); }
    }
  }
  if constexpr ((PH_MASK >> 14) & 1u) {
    if (p.ph_lo <= 14 && 14 < p.ph_hi) {
      if (14 > p.ph_lo) xcd_barrier(xb);
      phase_gemm_gu(p, smem, 1, true);
      if constexpr (DUP_PH == 14) { grid.sync(); phase_gemm_gu(p, smem, 1, true); }
    }
  }
  if constexpr ((PH_MASK >> 15) & 1u) {
    if (p.ph_lo <= 15 && 15 < p.ph_hi) {
      if (15 > p.ph_lo) xcd_barrier(xb);
      phase_gemm_resid(p, smem, (const u16*)(p.ws + OFF_BIG), DFF, (const u16*)(p.ws + OFF_W_DN) + (size_t)1024 * DFF, DFF, 1, 5, false, true);
      if constexpr (DUP_PH == 15) { grid.sync(); phase_gemm_resid(p, smem, (const u16*)(p.ws + OFF_BIG), DFF, (const u16*)(p.ws + OFF_W_DN) + (size_t)1024 * DFF, DFF, 1, 5, false, true); }
    }
  }
  if constexpr ((PH_MASK >> 16) & 1u) {
    if (p.ph_lo <= 16 && 16 < p.ph_hi) {
      if (16 > p.ph_lo) xcd_barrier(xb);
      phase_final(p);
      if constexpr (DUP_PH == 16) { grid.sync(); phase_final(p); }
    }
  }
}

extern "C" void kernel_launch(void* const* d_in, const int* in_sizes, int n_in, void* d_out, int out_size, void* d_ws,
                              size_t ws_size, hipStream_t stream) {
  static int grid_blocks = 0;
  if (!grid_blocks) {
    int dev = 0, cus = 0, per_cu = 0;
    hipGetDevice(&dev);
    hipDeviceGetAttribute(&cus, hipDeviceAttributeMultiprocessorCount, dev);
    hipOccupancyMaxActiveBlocksPerMultiprocessor(&per_cu, hybrid_trunk_kernel, 256, 0);
    if (per_cu > 2) per_cu = 2;
    if (per_cu < 1) per_cu = 1;
    grid_blocks = cus * per_cu;
  }
  if (ws_size < WS_NEED) fprintf(stderr, "workspace too small: %zu < %zu\n", ws_size, (size_t)WS_NEED);
  Params p{};
  const float** pf = (const float**)&p;
  for (int i = 0; i < 24; ++i) pf[i] = (const float*)d_in[i];
  p.out = (float*)d_out;
  p.ws = (char*)d_ws;
#if ONE_LAUNCH
  p.ph_lo = 0;
  p.ph_hi = N_PHASES;
  (void)hipMemsetAsync((char*)d_ws + OFF_BAR, 0, XCD_BAR_WORDS * sizeof(unsigned), stream);
  void* args[] = {&p};
  hipError_t e = hipLaunchCooperativeKernel((const void*)hybrid_trunk_kernel, dim3(grid_blocks), dim3(256), args, 0, stream);
  if (e != hipSuccess) fprintf(stderr, "cooperative launch failed: %s (grid %d)\n", hipGetErrorString(e), grid_blocks);
#else
  for (int ph = 0; ph < N_PHASES; ++ph) {
    p.ph_lo = ph;
    p.ph_hi = ph + 1;
    hipLaunchKernelGGL(hybrid_trunk_kernel, dim3(grid_blocks), dim3(256), 0, stream, p);
  }
#endif
}
```

```cpp
#include <hip/hip_runtime.h>
#include <hip/hip_cooperative_groups.h>
#include <cstdio>
namespace cg = cooperative_groups;

#define DI __device__ __forceinline__
typedef unsigned short u16;
typedef __attribute__((ext_vector_type(8))) short bf16x8;
typedef __attribute__((ext_vector_type(16))) float f32x16;
typedef __attribute__((ext_vector_type(2))) float f32x2;
typedef __attribute__((ext_vector_type(4))) unsigned u32x4;
typedef __attribute__((ext_vector_type(2))) unsigned u32x2;
#define MFMA32(a, b, c) __builtin_amdgcn_mfma_f32_32x32x16_bf16((a), (b), (c), 0, 0, 0)

#ifndef ONE_LAUNCH
#define ONE_LAUNCH 1
#endif

constexpr int NB = 4, SEQ = 8192, CTX = 256, UB = 8448, MROWS = 33792, DM = 1024, DFF = 2816;
constexpr int NPROJ = 4608;
constexpr float LOG2E = 1.4426950408889634f;
constexpr float EPS = 1e-6f;

constexpr size_t SZ_W_ATT = (size_t)3072 * 1024 * 2;
constexpr size_t SZ_W_REC = (size_t)4864 * 1024 * 2;
constexpr size_t SZ_W_MIX = (size_t)2 * 1024 * 1024 * 2;
constexpr size_t SZ_W_GU = (size_t)2 * 5632 * 1024 * 2;
constexpr size_t SZ_W_DN = (size_t)2 * 1024 * 2816 * 2;
constexpr size_t OFF_W_ATT = 0;
constexpr size_t OFF_W_REC = OFF_W_ATT + SZ_W_ATT;
constexpr size_t OFF_W_MIX = OFF_W_REC + SZ_W_REC;
constexpr size_t OFF_W_GU = OFF_W_MIX + SZ_W_MIX;
constexpr size_t OFF_W_DN = OFF_W_GU + SZ_W_GU;
constexpr size_t OFF_MOD = OFF_W_DN + SZ_W_DN;
constexpr size_t OFF_ROPE = OFF_MOD + (size_t)2 * 5 * 6144 * 4;
constexpr size_t OFF_MISC = OFF_ROPE + 128 * 16 * 2 * 4;
constexpr size_t OFF_BAR = OFF_MISC + 8192;
constexpr size_t OFF_XCTX = OFF_BAR + 16384;
constexpr size_t OFF_DAB = OFF_XCTX + (size_t)1024 * 1024 * 4;
constexpr size_t OFF_H = OFF_DAB + (size_t)MROWS * 16 * 4;
constexpr size_t OFF_OB = OFF_H + (size_t)MROWS * 1024 * 2;
constexpr size_t OFF_BIG = OFF_OB + (size_t)MROWS * 1024 * 2;
constexpr size_t OFF_VT = OFF_BIG + (size_t)MROWS * 2048 * 2;
constexpr size_t WS_TOTAL = OFF_BIG + (size_t)MROWS * NPROJ * 2;
constexpr int NSEG_G = 8, SEGC_G = 33, NHO_G = NSEG_G - 1;
constexpr int NSEG_H = 3, SEGC_H = 88, NHO_H = NSEG_H - 1;
constexpr size_t OFF_GS = OFF_W_ATT;
constexpr size_t OFF_HD = OFF_GS + (size_t)32 * NHO_G * 16384 * 4;
constexpr size_t OFF_GP = OFF_W_GU;
constexpr size_t OFF_HS = OFF_GP + (size_t)32 * NHO_G * 16384 * 2;
static_assert(OFF_HD + 32 * NHO_H * 128 * 4 <= OFF_W_MIX, "gdn states must fit in the dead att/rec weight region");
static_assert(OFF_HS + (size_t)32 * NHO_H * 16384 * 4 <= OFF_W_GU + SZ_W_GU / 2, "transitions + HGRN states must fit in layer-0 gate/up");
constexpr size_t WS_NEED = WS_TOTAL;

struct Params {
  const float *x, *c, *ctx, *c_ctx, *ada_w, *ada_b, *norm_mix, *norm_ffn, *w_mix_out, *ffn_gate, *ffn_up, *ffn_down,
      *att_w_in, *att_rpb, *att_lambda, *att_subln, *rec_w_in, *rec_lb_logits, *rec_conv_w, *rec_a_log, *rec_dt_bias,
      *rec_c_norm, *rec_d_norm, *final_norm;
  float* out;
  char* ws;
  int ph_lo, ph_hi;
};

DI u16 f2bf(float x) {
  unsigned u = __float_as_uint(x);
  u += 0x7fffu + ((u >> 16) & 1u);
  return (u16)(u >> 16);
}
DI float bf2f(u16 v) { return __uint_as_float(((unsigned)v) << 16); }
typedef __attribute__((ext_vector_type(2))) __bf16 bf16x2_t;
DI unsigned pack2(float a, float b) {
  f32x2 v = {a, b};
  return __builtin_bit_cast(unsigned, __builtin_convertvector(v, bf16x2_t));
}
DI float bflo(unsigned u) { return __uint_as_float(u << 16); }
DI float bfhi(unsigned u) { return __uint_as_float(u & 0xffff0000u); }
DI int crow(int reg, int h) { return (reg & 3) + 8 * (reg >> 2) + 4 * h; }
DI float sigmoidf_(float x) { return __builtin_amdgcn_rcpf(1.f + __expf(-x)); }
DI float siluf_(float x) { return x * __builtin_amdgcn_rcpf(1.f + __expf(-x)); }
DI float wave_sum(float v) {
#pragma unroll
  for (int o = 32; o > 0; o >>= 1) v += __shfl_xor(v, o);
  return v;
}
template <int CTRL>
DI float dpp_mov(float x) {
  return __builtin_bit_cast(float, __builtin_amdgcn_update_dpp(0, __builtin_bit_cast(int, x), CTRL, 0xF, 0xF, true));
}
DI float dpp_sum8(float x) {
  x += dpp_mov<0xB1>(x);
  x += dpp_mov<0x4E>(x);
  x += dpp_mov<0x141>(x);
  return x;
}
DI float dpp_sum16(float x) {
  x = dpp_sum8(x);
  x += dpp_mov<0x140>(x);
  return x;
}
DI void my_sincos(float a, float& s, float& c) {
  float q = rintf(a * 0.636619772f);
  float r = fmaf(-q, 1.57079637f, a);
  r = fmaf(-q, -4.37113883e-8f, r);
  int qi = ((int)q) & 3;
  float r2 = r * r;
  float sr = r + r * r2 * (-1.6666654611e-1f + r2 * (8.3321608736e-3f + r2 * (-1.9515295891e-4f)));
  float cr = 1.f - 0.5f * r2 + r2 * r2 * (4.166664568298827e-2f + r2 * (-1.388731625493765e-3f + r2 * 2.443315711809948e-5f));
  if (qi == 0) { s = sr; c = cr; }
  else if (qi == 1) { s = cr; c = -sr; }
  else if (qi == 2) { s = -sr; c = -cr; }
  else { s = -cr; c = sr; }
}
DI f32x16 zero16() {
  f32x16 z;
#pragma unroll
  for (int i = 0; i < 16; ++i) z[i] = 0.f;
  return z;
}
DI const float* row_in(const Params& p, int u) {
  int b = u / UB, uu = u - b * UB;
  return uu < CTX ? p.ctx + ((size_t)b * CTX + uu) * DM : p.x + ((size_t)b * SEQ + (uu - CTX)) * DM;
}
DI float* row_cur(const Params& p, int u) {
  int b = u / UB, uu = u - b * UB;
  return uu < CTX ? (float*)(p.ws + OFF_XCTX) + ((size_t)b * CTX + uu) * DM : p.out + ((size_t)b * SEQ + (uu - CTX)) * DM;
}
DI int mod_vec(int u) {
  int b = u / UB, uu = u - b * UB;
  return uu < CTX ? 4 : b;
}

#define XB_TMO      128
#define XB_XCNT(j)  (256  + 64 * (j))
#define XB_XSUB(j)  (1280 + 64 * (j))
#define XB_XGEN(j)  (2304 + 64 * (j))
#define XB_TOP      3328
#define XB_TOPGEN   3392
#define XCD_BAR_WORDS 3456
#define XB_SPIN_CAP (1u << 18)
#define LAS __attribute__((address_space(3)))
DI unsigned xb_ld(unsigned* p) { return __hip_atomic_load(p, __ATOMIC_RELAXED, __HIP_MEMORY_SCOPE_AGENT); }
DI unsigned xb_add(unsigned* p, unsigned v) { return __hip_atomic_fetch_add(p, v, __ATOMIC_RELAXED, __HIP_MEMORY_SCOPE_AGENT); }
DI unsigned xb_xcc_id() { return (unsigned)__builtin_amdgcn_s_getreg((3 << 11) | 20) & 0xFu; }
#define XB_SPIN(cond, bar) do { unsigned _sp = 0; while (cond) { __builtin_amdgcn_s_sleep(1); \
    if ((++_sp & 255u) == 0u) { if (xb_ld(&(bar)[XB_TMO])) break; if (_sp > XB_SPIN_CAP) { atomicAdd(&(bar)[XB_TMO], 1u); break; } } } } while (0)
struct XcdBarrier {
  unsigned* bar;
  unsigned x;
  volatile LAS unsigned* st;
};
DI XcdBarrier xcd_barrier_post(unsigned* bar, volatile LAS unsigned* st) {
  XcdBarrier b;
  b.bar = bar; b.x = xb_xcc_id(); b.st = st;
  if (threadIdx.x == 0) (void)xb_add(&bar[XB_XCNT(b.x)], 1u);
  return b;
}
DI void xcd_barrier_complete(unsigned* bar, unsigned x, unsigned& nloc, unsigned& nx) {
  const unsigned G = gridDim.x * gridDim.y * gridDim.z;
  unsigned sum, cnt, mine, sp = 0u;
  for (;;) {
    sum = 0u; cnt = 0u; mine = 0u;
#pragma unroll
    for (unsigned j = 0; j < 16; ++j) {
      const unsigned c = xb_ld(&bar[XB_XCNT(j)]);
      sum += c; cnt += (c > 0u) ? 1u : 0u; mine = (j == x) ? c : mine;
    }
    if (sum == G) break;
    __builtin_amdgcn_s_sleep(1);
    if ((++sp & 255u) == 0u) { if (xb_ld(&bar[XB_TMO])) break; if (sp > XB_SPIN_CAP) { atomicAdd(&bar[XB_TMO], 1u); break; } }
  }
  nloc = mine > 0u ? mine : 1u; nx = cnt > 0u ? cnt : 1u;
}
DI void xcd_barrier(const XcdBarrier& b) {
  asm volatile("s_waitcnt vmcnt(0)" ::: "memory");
  __syncthreads();
  if (threadIdx.x == 0) {
    unsigned* bar = b.bar;
    __builtin_amdgcn_s_waitcnt(0);
    unsigned nloc = b.st[0], nx = b.st[1];
    if (nloc == 0u) { xcd_barrier_complete(bar, b.x, nloc, nx); b.st[0] = nloc; b.st[1] = nx; }
    const unsigned old = xb_add(&bar[XB_XSUB(b.x)], 1u);
    const unsigned gen = old / nloc;
    if (old + 1u == (gen + 1u) * nloc) {
      __builtin_amdgcn_fence(__ATOMIC_RELEASE, "agent");
      asm volatile("s_waitcnt vmcnt(0)" ::: "memory");
      const unsigned og = xb_add(&bar[XB_TOP], 1u);
      const unsigned tg = og / nx;
      if (og + 1u == (tg + 1u) * nx) xb_add(&bar[XB_TOPGEN], 1u);
      else XB_SPIN(xb_ld(&bar[XB_TOPGEN]) == tg, bar);
      __builtin_amdgcn_fence(__ATOMIC_ACQUIRE, "agent");
      xb_add(&bar[XB_XGEN(b.x)], 1u);
      asm volatile("s_waitcnt vmcnt(0)" ::: "memory");
    } else {
      XB_SPIN(xb_ld(&bar[XB_XGEN(b.x)]) == gen, bar);
      __builtin_amdgcn_fence(__ATOMIC_ACQUIRE, "agent");
      asm volatile("s_waitcnt vmcnt(0)" ::: "memory");
    }
  }
  __syncthreads();
}

template <class F>
DI void conv_tile(float* tile, int k0, int n0, int K, u16* __restrict__ dst, F srcf) {
  const int tid = threadIdx.x;
#pragma unroll 4
  for (int i = 0; i < 16; ++i) {
    int idx = i * 256 + tid, kk = idx >> 6, nn = idx & 63;
    tile[kk * 65 + nn] = srcf(k0 + kk, n0 + nn);
  }
  __syncthreads();
#pragma unroll 4
  for (int i = 0; i < 8; ++i) {
    int idx = i * 256 + tid, nn = idx >> 5, kk = (idx & 31) * 2;
    *(unsigned*)(dst + (size_t)(n0 + nn) * K + k0 + kk) = pack2(tile[kk * 65 + nn], tile[(kk + 1) * 65 + nn]);
  }
  __syncthreads();
}

DI void phase_prep(const Params& p, char* smem) {
  const int tid = threadIdx.x;
  float* fs = (float*)smem;
  const int N_CONV = 768 + 1216 + 512 + 2816 + 1408;
  const int N_ITEMS = N_CONV + 192 + 1;
  for (int item = blockIdx.x; item < N_ITEMS; item += gridDim.x) {
    if (item < 768) {
      int kt = item / 48, nt = item % 48;
      const float* src = p.att_w_in;
      conv_tile(fs, kt * 64, nt * 64, 1024, (u16*)(p.ws + OFF_W_ATT), [&](int k, int n) {
        int seg = n >> 9;
        int sseg = seg == 2 ? 3 : seg == 3 ? 4 : seg == 4 ? 2 : seg;
        return src[(size_t)k * 3072 + sseg * 512 + (n & 511)];
      });
    } else if (item < 768 + 1216) {
      int it = item - 768, kt = it / 76, nt = it % 76;
      const float* src = p.rec_w_in;
      conv_tile(fs, kt * 64, nt * 64, 1024, (u16*)(p.ws + OFF_W_REC),
                [&](int k, int n) { return n < 4624 ? src[(size_t)k * 4624 + n] : 0.f; });
    } else if (item < 768 + 1216 + 512) {
      int it = item - 1984, l = it / 256, r = it % 256, kt = r / 16, nt = r % 16;
      const float* src = p.w_mix_out + (size_t)l * 1024 * 1024;
      conv_tile(fs, kt * 64, nt * 64, 1024, (u16*)(p.ws + OFF_W_MIX) + (size_t)l * 1024 * 1024,
                [&](int k, int n) { return src[(size_t)k * 1024 + n]; });
    } else if (item < 768 + 1216 + 512 + 2816) {
      int it = item - 2496, l = it / 1408, r = it % 1408, kt = r / 88, nt = r % 88;
      const float* sg = p.ffn_gate + (size_t)l * 1024 * DFF;
      const float* su = p.ffn_up + (size_t)l * 1024 * DFF;
      conv_tile(fs, kt * 64, nt * 64, 1024, (u16*)(p.ws + OFF_W_GU) + (size_t)l * 5632 * 1024, [&](int k, int n) {
        int blk = n >> 6, r6 = n & 63;
        return r6 < 32 ? sg[(size_t)k * DFF + blk * 32 + r6] : su[(size_t)k * DFF + blk * 32 + r6 - 32];
      });
    } else if (item < N_CONV) {
      int it = item - 5312, l = it / 704, r = it % 704, kt = r / 16, nt = r % 16;
      const float* src = p.ffn_down + (size_t)l * DFF * 1024;
      conv_tile(fs, kt * 64, nt * 64, DFF, (u16*)(p.ws + OFF_W_DN) + (size_t)l * 1024 * DFF,
                [&](int k, int n) { return src[(size_t)k * 1024 + n]; });
    } else if (item < N_CONV + 192) {
      int it = item - N_CONV, l = it / 96, cb = it % 96;
      float* s = fs;
      float* red = fs + 5 * 1024;
      for (int i = tid; i < 5 * 1024; i += 256) {
        int v = i >> 10, k = i & 1023;
        float cv = v < 4 ? p.c[v * 1024 + k] : p.c_ctx[k];
        s[i] = siluf_(cv);
      }
      __syncthreads();
      int ci = tid & 63, kg = tid >> 6, col = cb * 64 + ci;
      float acc[5] = {0.f, 0.f, 0.f, 0.f, 0.f};
      const float* w = p.ada_w + (size_t)l * 1024 * 6144 + col;
      for (int k = kg; k < 1024; k += 4) {
        float wv = w[(size_t)k * 6144];
#pragma unroll
        for (int v = 0; v < 5; ++v) acc[v] += s[v * 1024 + k] * wv;
      }
#pragma unroll
      for (int v = 0; v < 5; ++v) red[(kg * 5 + v) * 64 + ci] = acc[v];
      __syncthreads();
      if (kg == 0) {
        float* mod = (float*)(p.ws + OFF_MOD);
#pragma unroll
        for (int v = 0; v < 5; ++v) {
          float t = red[(0 * 5 + v) * 64 + ci] + red[(1 * 5 + v) * 64 + ci] + red[(2 * 5 + v) * 64 + ci] + red[(3 * 5 + v) * 64 + ci];
          mod[(size_t)(l * 5 + v) * 6144 + col] = t + p.ada_b[l * 6144 + col];
        }
      }
      __syncthreads();
    } else {
      float* rope = (float*)(p.ws + OFF_ROPE);
      float* misc = (float*)(p.ws + OFF_MISC);
      for (int i = tid; i < 128 * 16; i += 256) {
        int pos = i >> 4, fi = i & 15;
        float invf = exp2f(-(float)fi * (13.287712379549449f / 16.f));
        float s, c;
        my_sincos((float)pos * invf, s, c);
        rope[i * 2] = c;
        rope[i * 2 + 1] = s;
      }
      for (int i = tid; i < 1024; i += 256) {
        float l0 = p.rec_lb_logits[i], l1 = p.rec_lb_logits[1024 + i];
        misc[16 + i] = 1.f / (1.f + expf(l0 - l1));
      }
      if (tid < 64) {
        float a = p.att_lambda[tid] * p.att_lambda[64 + tid];
        float b = p.att_lambda[128 + tid] * p.att_lambda[192 + tid];
        a = wave_sum(a);
        b = wave_sum(b);
        if (tid == 0) misc[0] = expf(a) - expf(b) + 0.2f;
      }
    }
  }
}

DI void norm_row(const float* __restrict__ src, const float* __restrict__ w, const float* __restrict__ shift,
                 const float* __restrict__ scale, u16* __restrict__ dst, int lane) {
  float4 v[4];
  float ss = 0.f;
#pragma unroll
  for (int i = 0; i < 4; ++i) {
    v[i] = ((const float4*)src)[lane + i * 64];
    ss += v[i].x * v[i].x + v[i].y * v[i].y + v[i].z * v[i].z + v[i].w * v[i].w;
  }
  ss = wave_sum(ss);
  float rs = rsqrtf(ss * (1.f / 1024.f) + EPS);
#pragma unroll
  for (int i = 0; i < 4; ++i) {
    int c4 = lane + i * 64;
    float4 ww = ((const float4*)w)[c4], sh = ((const float4*)shift)[c4], sc = ((const float4*)scale)[c4];
    float a = v[i].x * rs * ww.x * (1.f + sc.x) + sh.x;
    float b = v[i].y * rs * ww.y * (1.f + sc.y) + sh.y;
    float c = v[i].z * rs * ww.z * (1.f + sc.z) + sh.z;
    float d = v[i].w * rs * ww.w * (1.f + sc.w) + sh.w;
    uint2 o;
    o.x = pack2(a, b);
    o.y = pack2(c, d);
    ((uint2*)dst)[c4] = o;
  }
}
DI void phase_norm(const Params& p, int layer, int which, bool skip_ctx) {
  const int lane = threadIdx.x & 63, wave = threadIdx.x >> 6;
  const float* mod = (const float*)(p.ws + OFF_MOD);
  u16* H = (u16*)(p.ws + OFF_H);
  for (int item = blockIdx.x; item < MROWS / 4; item += gridDim.x) {
    int u = item * 4 + wave;
    int uu = u % UB;
    if (skip_ctx && uu < CTX) continue;
    const float* src = (which == 0) ? row_in(p, u) : row_cur(p, u);
    const float* w = (which == 1 ? p.norm_ffn : p.norm_mix) + layer * 1024;
    const float* mv = mod + (size_t)(layer * 5 + mod_vec(u)) * 6144 + (which == 1 ? 3 * 1024 : 0);
    norm_row(src, w, mv, mv + 1024, H + (size_t)u * 1024, lane);
  }
}
DI void phase_final(const Params& p) {
  const int lane = threadIdx.x & 63, wave = threadIdx.x >> 6;
  for (int item = blockIdx.x; item < NB * SEQ / 4; item += gridDim.x) {
    float* row = p.out + (size_t)(item * 4 + wave) * 1024;
    float4 v[4];
    float ss = 0.f;
#pragma unroll
    for (int i = 0; i < 4; ++i) {
      v[i] = ((const float4*)row)[lane + i * 64];
      ss += v[i].x * v[i].x + v[i].y * v[i].y + v[i].z * v[i].z + v[i].w * v[i].w;
    }
    ss = wave_sum(ss);
    float rs = rsqrtf(ss * (1.f / 1024.f) + EPS);
#pragma unroll
    for (int i = 0; i < 4; ++i) {
      float4 ww = ((const float4*)p.final_norm)[lane + i * 64];
      float4 o;
      o.x = v[i].x * rs * ww.x; o.y = v[i].y * rs * ww.y; o.z = v[i].z * rs * ww.z; o.w = v[i].w * rs * ww.w;
      ((float4*)row)[lane + i * 64] = o;
    }
  }
}

DI bool gemm_tile_of(int it, int NT, int& mt, int& nt) {
  if ((gridDim.x & 7) != 0) {
    int item = it * gridDim.x + blockIdx.x;
    if (item >= 264 * NT) return false;
    mt = item / NT; nt = item % NT;
    return true;
  }
  const int xcd = blockIdx.x & 7, lw = blockIdx.x >> 3, wpx = gridDim.x >> 3;
  int idx = it * wpx + lw;
  if (idx >= 33 * NT) return false;
  const int nfull = NT >> 3, full_items = nfull * 33 * 8;
  int ml;
  if (idx < full_items) {
    int nb = idx / 264, rem = idx - nb * 264;
    ml = rem >> 3; nt = nb * 8 + (rem & 7);
  } else {
    int i2 = idx - full_items, w = NT - nfull * 8;
    ml = i2 / w; nt = nfull * 8 + (i2 - ml * w);
  }
  mt = xcd * 33 + ml;
  return true;
}

DI void gemm_core(const u16* __restrict__ A, int lda, const u16* __restrict__ Wt, int K, int m0, int n0, char* smem,
                  f32x16 (&acc)[2][2]) {
  u16* As = (u16*)smem;
  u16* Bs = As + 2 * 128 * 72;
  const int tid = threadIdx.x, lane = tid & 63, wave = tid >> 6;
  const int wm = (wave >> 1) * 64, wn = (wave & 1) * 64;
  const int r = lane & 31, h = lane >> 5;
#pragma unroll
  for (int i = 0; i < 2; ++i)
#pragma unroll
    for (int j = 0; j < 2; ++j) acc[i][j] = zero16();
  u32x4 ra0[4], rb0[4], ra1[4], rb1[4];
  const int lrow = tid >> 3, lcc = (tid & 7) * 8;
  const u16* ag = A + (size_t)(m0 + lrow) * lda + lcc;
  const u16* bg = Wt + (size_t)(n0 + lrow) * K + lcc;
  const int nk = K >> 6;
#define GLOAD(RA, RB, KT)                                                   \
  _Pragma("unroll") for (int i = 0; i < 4; ++i) {                           \
    RA[i] = *(const u32x4*)(ag + (size_t)(i * 32) * lda + (KT) * 64);       \
    RB[i] = *(const u32x4*)(bg + (size_t)(i * 32) * K + (KT) * 64);         \
  }
#define SSTORE(RA, RB, BUF)                                                 \
  _Pragma("unroll") for (int i = 0; i < 4; ++i) {                           \
    *(u32x4*)(As + (BUF) * 128 * 72 + (lrow + i * 32) * 72 + lcc) = RA[i];  \
    *(u32x4*)(Bs + (BUF) * 128 * 72 + (lrow + i * 32) * 72 + lcc) = RB[i];  \
  }
#define COMPUTE(BUF)                                                                        \
  _Pragma("unroll") for (int ks = 0; ks < 4; ++ks) {                                        \
    const u16* as = As + (BUF) * 128 * 72;                                                  \
    const u16* bs = Bs + (BUF) * 128 * 72;                                                  \
    bf16x8 a0 = *(const bf16x8*)(as + (wm + r) * 72 + ks * 16 + h * 8);                     \
    bf16x8 a1 = *(const bf16x8*)(as + (wm + 32 + r) * 72 + ks * 16 + h * 8);                \
    bf16x8 b0 = *(const bf16x8*)(bs + (wn + r) * 72 + ks * 16 + h * 8);                     \
    bf16x8 b1 = *(const bf16x8*)(bs + (wn + 32 + r) * 72 + ks * 16 + h * 8);                \
    acc[0][0] = MFMA32(a0, b0, acc[0][0]);                                                  \
    acc[0][1] = MFMA32(a0, b1, acc[0][1]);                                                  \
    acc[1][0] = MFMA32(a1, b0, acc[1][0]);                                                  \
    acc[1][1] = MFMA32(a1, b1, acc[1][1]);                                                  \
  }
  GLOAD(ra0, rb0, 0)
  GLOAD(ra1, rb1, 1)
  __syncthreads();
  SSTORE(ra0, rb0, 0)
  __syncthreads();
  if (nk > 2) { GLOAD(ra0, rb0, 2) }
  for (int it = 0; it < nk; it += 2) {
    COMPUTE(0)
    SSTORE(ra1, rb1, 1)
    __syncthreads();
    if (it + 3 < nk) { GLOAD(ra1, rb1, it + 3) }
    COMPUTE(1)
    if (it + 2 < nk) { SSTORE(ra0, rb0, 0) }
    __syncthreads();
    if (it + 4 < nk) { GLOAD(ra0, rb0, it + 4) }
  }
#undef GLOAD
#undef SSTORE
#undef COMPUTE
}

DI void gemm_core256(const u16* __restrict__ A, int lda, const u16* __restrict__ Wt, int K, int m0, int n0, char* smem,
                     f32x16 (&acc)[2][4]) {
  constexpr int PT = 40;
  u16* As = (u16*)smem;
  u16* Bs = As + 2 * 128 * PT;
  const int tid = threadIdx.x, lane = tid & 63, wave = tid >> 6;
  const int wm = (wave >> 1) * 64, wn = (wave & 1) * 128;
  const int r = lane & 31, h = lane >> 5;
#pragma unroll
  for (int i = 0; i < 2; ++i)
#pragma unroll
    for (int j = 0; j < 4; ++j) acc[i][j] = zero16();
  u32x4 ra0[2], rb0[4], ra1[2], rb1[4];
  const int lrow = tid >> 2, lcc = (tid & 3) * 8;
  const u16* ag = A + (size_t)(m0 + lrow) * lda + lcc;
  const u16* bg = Wt + (size_t)(n0 + lrow) * K + lcc;
  const int nk = K >> 5;
#define GLOAD(RA, RB, KT)                                                                          \
  _Pragma("unroll") for (int i = 0; i < 2; ++i) RA[i] = *(const u32x4*)(ag + (size_t)(i * 64) * lda + (KT) * 32); \
  _Pragma("unroll") for (int i = 0; i < 4; ++i) RB[i] = *(const u32x4*)(bg + (size_t)(i * 64) * K + (KT) * 32);
#define SSTORE(RA, RB, BUF)                                                                        \
  _Pragma("unroll") for (int i = 0; i < 2; ++i) *(u32x4*)(As + (BUF) * 128 * PT + (lrow + i * 64) * PT + lcc) = RA[i]; \
  _Pragma("unroll") for (int i = 0; i < 4; ++i) *(u32x4*)(Bs + (BUF) * 256 * PT + (lrow + i * 64) * PT + lcc) = RB[i];
#define COMPUTE(BUF)                                                                               \
  _Pragma("unroll") for (int ks = 0; ks < 2; ++ks) {                                               \
    const u16* as = As + (BUF) * 128 * PT;                                                         \
    const u16* bs = Bs + (BUF) * 256 * PT;                                                         \
    bf16x8 a0 = *(const bf16x8*)(as + (wm + r) * PT + ks * 16 + h * 8);                            \
    bf16x8 a1 = *(const bf16x8*)(as + (wm + 32 + r) * PT + ks * 16 + h * 8);                       \
    _Pragma("unroll") for (int j = 0; j < 4; ++j) {                                                \
      bf16x8 bj = *(const bf16x8*)(bs + (wn + 32 * j + r) * PT + ks * 16 + h * 8);                 \
      acc[0][j] = MFMA32(a0, bj, acc[0][j]);                                                       \
      acc[1][j] = MFMA32(a1, bj, acc[1][j]);                                                       \
    }                                                                                              \
  }
  GLOAD(ra0, rb0, 0)
  GLOAD(ra1, rb1, 1)
  __syncthreads();
  SSTORE(ra0, rb0, 0)
  __syncthreads();
  if (nk > 2) { GLOAD(ra0, rb0, 2) }
  for (int it = 0; it < nk; it += 2) {
    COMPUTE(0)
    SSTORE(ra1, rb1, 1)
    __syncthreads();
    if (it + 3 < nk) { GLOAD(ra1, rb1, it + 3) }
    COMPUTE(1)
    if (it + 2 < nk) { SSTORE(ra0, rb0, 0) }
    __syncthreads();
    if (it + 4 < nk) { GLOAD(ra0, rb0, it + 4) }
  }
#undef GLOAD
#undef SSTORE
#undef COMPUTE
}

DI void phase_gemm_att_in(const Params& p, char* smem) {
  const u16* H = (const u16*)(p.ws + OFF_H);
  const u16* W = (const u16*)(p.ws + OFF_W_ATT);
  u16* QK = (u16*)(p.ws + OFF_BIG);
  u16* VT = (u16*)(p.ws + OFF_VT);
  const float* rope = (const float*)(p.ws + OFF_ROPE);
  const int lane = threadIdx.x & 63, wave = threadIdx.x >> 6;
  const int wm = (wave >> 1) * 64, wn = (wave & 1) * 64, r = lane & 31, h = lane >> 5;
  const int NT = 24, MT = MROWS / 128;
  for (int it = 0;; ++it) {
    int mt, nt;
    if (!gemm_tile_of(it, NT, mt, nt)) break;
    int m0 = mt * 128, n0 = nt * 128;
    f32x16 acc[2][2];
    gemm_core(H, 1024, W, 1024, m0, n0, smem, acc);
    int seg = n0 >> 9;
    int b = m0 / UB, uu0 = m0 - b * UB;
    bool lat = uu0 >= CTX;
    if (seg < 4) {
      bool dorope = lat && seg >= 2;
#pragma unroll
      for (int i = 0; i < 2; ++i)
#pragma unroll
        for (int j = 0; j < 2; ++j) {
          int n = n0 + wn + 32 * j + r;
#pragma unroll
          for (int g = 0; g < 16; ++g) {
            int mrow = m0 + wm + 32 * i + crow(g, h);
            float v = acc[i][j][g];
            if (seg >= 2) {
              float pv = __shfl_xor(v, 16);
              if (dorope) {
                int t = uu0 + wm + 32 * i + crow(g, h) - CTX;
                int pos = (j == 0) ? (t >> 6) : (t & 63);
                float2 cs = ((const float2*)rope)[pos * 16 + (r & 15)];
                v = v * cs.x + ((r < 16) ? -pv : pv) * cs.y;
              }
            }
            QK[(size_t)mrow * 2048 + n] = f2bf(v);
          }
        }
    } else {
#pragma unroll
      for (int i = 0; i < 2; ++i)
#pragma unroll
        for (int j = 0; j < 2; ++j) {
          int vc = n0 - 2048 + wn + 32 * j + r;
          u16* vrow = VT + ((size_t)b * 1024 + vc) * UB;
#pragma unroll
          for (int g4 = 0; g4 < 4; ++g4) {
            int tok = uu0 + wm + 32 * i + 8 * g4 + 4 * h;
            uint2 o;
            o.x = pack2(acc[i][j][4 * g4], acc[i][j][4 * g4 + 1]);
            o.y = pack2(acc[i][j][4 * g4 + 2], acc[i][j][4 * g4 + 3]);
            *(uint2*)(vrow + tok) = o;
          }
        }
    }
  }
}

DI void phase_gemm_resid(const Params& p, char* smem, const u16* A, int lda, const u16* W, int K, int layer, int gate_chunk,
                         bool first, bool skip_ctx) {
  const float* mod = (const float*)(p.ws + OFF_MOD);
  const int lane = threadIdx.x & 63, wave = threadIdx.x >> 6;
  const int wm = (wave >> 1) * 64, wn = (wave & 1) * 64, r = lane & 31, h = lane >> 5;
  const int NT = 8, MT = MROWS / 128;
  for (int it = 0;; ++it) {
    int mt, nt;
    if (!gemm_tile_of(it, NT, mt, nt)) break;
    if (skip_ctx && (mt % 66) < 2) continue;
    int m0 = mt * 128, n0 = nt * 128;
    f32x16 acc[2][2];
    gemm_core(A, lda, W, K, m0, n0, smem, acc);
    const float* gv = mod + (size_t)(layer * 5 + mod_vec(m0)) * 6144 + gate_chunk * 1024;
    const float* src0 = (first ? row_in(p, m0) : row_cur(p, m0)) + n0 + wn + r;
    float* dst0 = row_cur(p, m0) + n0 + wn + r;
    const float g0 = gv[n0 + wn + r], g1 = gv[n0 + wn + 32 + r];
    int hq = h;
    asm volatile("" : "+v"(hq));
#pragma unroll
    for (int i = 0; i < 2; ++i)
#pragma unroll
      for (int g = 0; g < 16; ++g) {
        const int ro = (wm + 32 * i + crow(g, hq)) * 1024;
        dst0[ro] = src0[ro] + g0 * acc[i][0][g];
        dst0[ro + 32] = src0[ro + 32] + g1 * acc[i][1][g];
      }
  }
}

DI void phase_gemm_gu(const Params& p, char* smem, int layer, bool skip_ctx) {
  const u16* H = (const u16*)(p.ws + OFF_H);
  const u16* W = (const u16*)(p.ws + OFF_W_GU) + (size_t)layer * 5632 * 1024;
  u16* ACT = (u16*)(p.ws + OFF_BIG);
  const int lane = threadIdx.x & 63, wave = threadIdx.x >> 6;
  const int wm = (wave >> 1) * 64, wn = (wave & 1) * 128, r = lane & 31, h = lane >> 5;
  const int NT = 22;
  for (int it = 0;; ++it) {
    int mt, nt;
    if (!gemm_tile_of(it, NT, mt, nt)) break;
    if (skip_ctx && (mt % 66) < 2) continue;
    int m0 = mt * 128, n0 = nt * 256;
    f32x16 acc[2][4];
    gemm_core256(H, 1024, W, 1024, m0, n0, smem, acc);
    int col = ((n0 + wn) >> 1) + r;
#pragma unroll
    for (int i = 0; i < 2; ++i)
#pragma unroll
      for (int g = 0; g < 16; ++g) {
        int mrow = m0 + wm + 32 * i + crow(g, h);
        ACT[(size_t)mrow * DFF + col] = f2bf(siluf_(acc[i][0][g]) * acc[i][1][g]);
        ACT[(size_t)mrow * DFF + col + 32] = f2bf(siluf_(acc[i][2][g]) * acc[i][3][g]);
      }
  }
}

DI void phase_gemm_rec_in(const Params& p, char* smem) {
  const u16* H = (const u16*)(p.ws + OFF_H);
  const u16* W = (const u16*)(p.ws + OFF_W_REC);
  u16* PROJ = (u16*)(p.ws + OFF_BIG);
  float* DAB = (float*)(p.ws + OFF_DAB);
  const int lane = threadIdx.x & 63, wave = threadIdx.x >> 6;
  const int wm = (wave >> 1) * 64, wn = (wave & 1) * 128, r = lane & 31, h = lane >> 5;
  const int NT = 19;
  for (int it = 0;; ++it) {
    int mt, nt;
    if (!gemm_tile_of(it, NT, mt, nt)) break;
    int m0 = mt * 128, n0 = nt * 256;
    f32x16 acc[2][4];
    gemm_core256(H, 1024, W, 1024, m0, n0, smem, acc);
#pragma unroll
    for (int i = 0; i < 2; ++i)
#pragma unroll
      for (int j = 0; j < 4; ++j) {
        int n = n0 + wn + 32 * j + r;
#pragma unroll
        for (int g = 0; g < 16; ++g) {
          int mrow = m0 + wm + 32 * i + crow(g, h);
          float v = acc[i][j][g];
          if (n < 4096) PROJ[(size_t)mrow * NPROJ + n] = f2bf(v);
          else if (n >= 4112 && n < 4624) PROJ[(size_t)mrow * NPROJ + n - 16] = f2bf(v);
        }
      }
    if (n0 + wn == 4096 && r < 16) {
      const float dtb = p.rec_dt_bias[r & 7], ar = expf(p.rec_a_log[r & 7]);
#pragma unroll
      for (int i = 0; i < 2; ++i)
#pragma unroll
        for (int g = 0; g < 16; ++g) {
          const int mrow = m0 + wm + 32 * i + crow(g, h);
          const float v = acc[i][0][g];
          float o;
          if (r < 8) {
            const float xx = v + dtb;
            const float sp = xx > 20.f ? xx : log1pf(expf(xx));
            o = -ar * sp;
          } else {
            o = 1.f / (1.f + expf(-v));
          }
          DAB[(size_t)mrow * 16 + r] = o;
        }
    }
  }
}

constexpr int ATT_KS = 64 * 72;
template <int DV>
DI void attn_job(const u16* __restrict__ qk, size_t qrow, int qcol, int kcol, size_t kbase, const u16* __restrict__ vt,
                 int s0, int n0, int s1, int n1, bool na, int na_rlo, int na_r0w, int na_rq, int na_qc,
                 const float* rpb_lds, char* smem, f32x16 (&O)[DV / 32], float& l_out) {
  u16* Ks = (u16*)smem;
  u16* Vs = Ks + 2 * ATT_KS;
  constexpr int NV = DV / 32;
  const int tid = threadIdx.x, lane = tid & 63, r = lane & 31, h = lane >> 5;
  bf16x8 qf[4];
#pragma unroll
  for (int s = 0; s < 4; ++s) qf[s] = *(const bf16x8*)(qk + (qrow + r) * 2048 + qcol + 16 * s + 8 * h);
#pragma unroll
  for (int d = 0; d < NV; ++d) O[d] = zero16();
  float m = -1e30f, l = 0.f;
  const float sc = 0.125f * LOG2E;
  const int nt = n0 + n1;
  const int lrow = tid >> 3, lcc = (tid & 7) * 8;
  u32x4 rk[2], rv[NV];
  auto gload = [&](int t) {
    const int tok0 = t < n0 ? s0 + 64 * t : s1 + 64 * (t - n0);
#pragma unroll
    for (int i = 0; i < 2; ++i) rk[i] = *(const u32x4*)(qk + (kbase + tok0 + lrow + 32 * i) * 2048 + kcol + lcc);
#pragma unroll
    for (int i = 0; i < NV; ++i) rv[i] = *(const u32x4*)(vt + (size_t)(lrow + 32 * i) * UB + tok0 + lcc);
  };
  auto sstore = [&](int buf) {
#pragma unroll
    for (int i = 0; i < 2; ++i) *(u32x4*)(Ks + buf * ATT_KS + (lrow + 32 * i) * 72 + lcc) = rk[i];
#pragma unroll
    for (int i = 0; i < NV; ++i) *(u32x4*)(Vs + buf * DV * 72 + (lrow + 32 * i) * 72 + lcc) = rv[i];
  };
  gload(0);
  sstore(0);
  __syncthreads();
  for (int t = 0; t < nt; ++t) {
    const int buf = t & 1;
    if (t + 1 < nt) gload(t + 1);
    bool active = true;
    int kr = 0;
    if (na && t >= n0) {
      kr = na_rlo + (t - n0);
      active = (kr >= na_r0w) && (kr < na_r0w + 8);
    }
    if (active) {
      const u16* kb = Ks + buf * ATT_KS;
      const u16* vb = Vs + buf * DV * 72;
      f32x16 S0 = zero16(), S1 = zero16();
#pragma unroll
      for (int s = 0; s < 4; ++s) {
        bf16x8 a0 = *(const bf16x8*)(kb + r * 72 + 16 * s + 8 * h);
        bf16x8 a1 = *(const bf16x8*)(kb + (32 + r) * 72 + 16 * s + 8 * h);
        S0 = MFMA32(a0, qf[s], S0);
        S1 = MFMA32(a1, qf[s], S1);
      }
      float tv[32];
#pragma unroll
      for (int i = 0; i < 16; ++i) {
        tv[i] = S0[i] * sc;
        tv[16 + i] = S1[i] * sc;
      }
      if (na && t >= n0) {
        const int cs = min(max(na_qc - 8, 0), 48);
        const float* brow = rpb_lds + (kr - na_rq + 7) * 31;
#pragma unroll
        for (int i = 0; i < 32; ++i) {
          int kc = (i >> 4) * 32 + crow(i & 15, h);
          bool ok = (kc >= cs) && (kc < cs + 16);
          int ci = min(max(kc - na_qc + 15, 0), 30);
          float bias = brow[ci];
          tv[i] = ok ? tv[i] + bias * LOG2E : -1e30f;
        }
      }
      float tm = tv[0];
#pragma unroll
      for (int i = 1; i < 32; ++i) tm = fmaxf(tm, tv[i]);
      {
        auto rr = __builtin_amdgcn_permlane32_swap(__float_as_uint(tm), __float_as_uint(tm), false, false);
        tm = fmaxf(__uint_as_float(rr[0]), __uint_as_float(rr[1]));
      }
      float mn = m;
      if (!__all(tm - m <= 8.f)) {
        mn = fmaxf(m, tm);
        const float alpha = __builtin_amdgcn_exp2f(m - mn);
        m = mn;
        l *= alpha;
#pragma unroll
        for (int d = 0; d < NV; ++d)
#pragma unroll
          for (int i = 0; i < 16; ++i) O[d][i] *= alpha;
      }
      float ps = 0.f;
#pragma unroll
      for (int i = 0; i < 32; ++i) {
        tv[i] = __builtin_amdgcn_exp2f(tv[i] - mn);
        ps += tv[i];
      }
      l += ps;
      bf16x8 pf[4];
#pragma unroll
      for (int s = 0; s < 4; ++s) {
        u32x4 u;
        u.x = pack2(tv[8 * s], tv[8 * s + 1]);
        u.y = pack2(tv[8 * s + 2], tv[8 * s + 3]);
        u.z = pack2(tv[8 * s + 4], tv[8 * s + 5]);
        u.w = pack2(tv[8 * s + 6], tv[8 * s + 7]);
        pf[s] = __builtin_bit_cast(bf16x8, u);
      }
#pragma unroll
      for (int d = 0; d < NV; ++d) {
        const u16* vp = vb + (32 * d + r) * 72 + 4 * h;
#pragma unroll
        for (int s = 0; s < 4; ++s) {
          u32x2 lo = *(const u32x2*)(vp + 16 * s);
          u32x2 hi = *(const u32x2*)(vp + 16 * s + 8);
          u32x4 u;
          u.x = lo.x; u.y = lo.y; u.z = hi.x; u.w = hi.y;
          O[d] = MFMA32(__builtin_bit_cast(bf16x8, u), pf[s], O[d]);
        }
      }
    }
    if (t + 1 < nt) sstore(buf ^ 1);
    __syncthreads();
  }
  l_out = l + __shfl_xor(l, 32);
}

DI void phase_attn(const Params& p, char* smem) {
  const u16* QK = (const u16*)(p.ws + OFF_BIG);
  const u16* VT = (const u16*)(p.ws + OFF_VT);
  u16* Y = (u16*)(p.ws + OFF_H);
  const float lam = ((const float*)(p.ws + OFF_MISC))[0];
  float* rpb_lds = (float*)(smem + 2 * (ATT_KS + 128 * 72) * 2);
  const int tid = threadIdx.x, lane = tid & 63, wave = tid >> 6, r = lane & 31, h = lane >> 5;
  const int N_A = 1024, N_B = 2048, N_D = 32, N_C = 64;
  for (int item = blockIdx.x; item < N_A + N_B + N_D + N_C; item += gridDim.x) {
    const bool is_diff = item < N_A || (item >= N_A + N_B && item < N_A + N_B + N_D);
    if (is_diff) {
      int b, hd, uu, ntile;
      if (item < N_A) {
        int grp = item >> 6, qt = item & 63;
        if ((gridDim.x & 7) == 0 && gridDim.x >= 512) {
          int lin = (item / (int)gridDim.x) * (gridDim.x >> 3) + (blockIdx.x >> 3);
          grp = (blockIdx.x & 7) + 8 * (lin >> 6);
          qt = lin & 63;
        }
        b = grp >> 2; hd = grp & 3;
        uu = CTX + qt * 128 + wave * 32;
        ntile = UB / 64;
      } else {
        int it = item - N_A - N_B;
        b = it >> 3; hd = (it >> 1) & 3;
        uu = (it & 1) * 128 + wave * 32;
        ntile = CTX / 64;
      }
      const u16* vt = VT + ((size_t)b * 1024 + 512 + hd * 128) * UB;
      f32x16 O[4];
      float l;
      u16* yrow = Y + ((size_t)b * UB + uu + r) * 1024 + 512 + hd * 128;
      attn_job<128>(QK, (size_t)b * UB + uu, 1024 + hd * 128, 1536 + hd * 128, (size_t)b * UB, vt, 0, ntile, 0, 0, false, 0, 0, 0,
                    0, nullptr, smem, O, l);
      {
        float inv = 1.f / l;
#pragma unroll
        for (int d = 0; d < 4; ++d)
#pragma unroll
          for (int g4 = 0; g4 < 4; ++g4) {
            u32x2 o;
            o.x = pack2(O[d][4 * g4] * inv, O[d][4 * g4 + 1] * inv);
            o.y = pack2(O[d][4 * g4 + 2] * inv, O[d][4 * g4 + 3] * inv);
            *(u32x2*)(yrow + 32 * d + 8 * g4 + 4 * h) = o;
          }
      }
      attn_job<128>(QK, (size_t)b * UB + uu, 1024 + hd * 128 + 64, 1536 + hd * 128 + 64, (size_t)b * UB, vt, 0, ntile, 0, 0, false,
                    0, 0, 0, 0, nullptr, smem, O, l);
      float f = lam / l;
      float ss = 0.f;
#pragma unroll
      for (int d = 0; d < 4; ++d)
#pragma unroll
        for (int g4 = 0; g4 < 4; ++g4) {
          u32x2 o1 = *(const u32x2*)(yrow + 32 * d + 8 * g4 + 4 * h);
          float a0 = bflo(o1.x) - O[d][4 * g4] * f, a1 = bfhi(o1.x) - O[d][4 * g4 + 1] * f;
          float a2 = bflo(o1.y) - O[d][4 * g4 + 2] * f, a3 = bfhi(o1.y) - O[d][4 * g4 + 3] * f;
          O[d][4 * g4] = a0; O[d][4 * g4 + 1] = a1; O[d][4 * g4 + 2] = a2; O[d][4 * g4 + 3] = a3;
          ss += a0 * a0 + a1 * a1 + a2 * a2 + a3 * a3;
        }
      ss += __shfl_xor(ss, 32);
      float rs = rsqrtf(ss * (1.f / 128.f) + EPS) * 0.8f;
#pragma unroll
      for (int d = 0; d < 4; ++d)
#pragma unroll
        for (int g4 = 0; g4 < 4; ++g4) {
          int dd = 32 * d + 8 * g4 + 4 * h;
          float4 sw = *(const float4*)(p.att_subln + dd);
          u32x2 o;
          o.x = pack2(O[d][4 * g4] * rs * sw.x, O[d][4 * g4 + 1] * rs * sw.y);
          o.y = pack2(O[d][4 * g4 + 2] * rs * sw.z, O[d][4 * g4 + 3] * rs * sw.w);
          *(u32x2*)(yrow + dd) = o;
        }
    } else {
      int b, hh, uu, s1 = 0, n1 = 0, rlo = 0, r0w = 0, rq = 0, qc = 0;
      bool na = false;
      if (item < N_A + N_B) {
        int it = item - N_A;
        b = it >> 9; hh = (it >> 6) & 7;
        int rp = it & 63;
        rq = rp * 2 + (wave >> 1);
        int half = wave & 1;
        uu = CTX + rq * 64 + half * 32;
        rlo = min(max(rp * 2 - 4, 0), 120);
        int rhi = min(max(rp * 2 + 1 - 4, 0), 120);
        r0w = min(max(rq - 4, 0), 120);
        s1 = CTX + rlo * 64;
        n1 = rhi - rlo + 8;
        qc = half * 32 + r;
        na = true;
        __syncthreads();
        for (int i = tid; i < 15 * 31; i += 256) rpb_lds[i] = p.att_rpb[hh * 15 * 31 + i];
      } else {
        int it = item - N_A - N_B - N_D;
        b = it >> 4; hh = (it >> 1) & 7;
        uu = (it & 1) * 128 + wave * 32;
      }
      f32x16 O[2];
      float l;
      attn_job<64>(QK, (size_t)b * UB + uu, hh * 64, 512 + hh * 64, (size_t)b * UB, VT + ((size_t)b * 1024 + hh * 64) * UB, 0,
                   CTX / 64, s1, n1, na, rlo, r0w, rq, qc, rpb_lds, smem, O, l);
      float inv = 1.f / l;
      u16* yrow = Y + ((size_t)b * UB + uu + r) * 1024 + hh * 64;
#pragma unroll
      for (int d = 0; d < 2; ++d)
#pragma unroll
        for (int g4 = 0; g4 < 4; ++g4) {
          int dd = 32 * d + 8 * g4 + 4 * h;
          u32x2 o;
          o.x = pack2(O[d][4 * g4] * inv, O[d][4 * g4 + 1] * inv);
          o.y = pack2(O[d][4 * g4 + 2] * inv, O[d][4 * g4 + 3] * inv);
          *(u32x2*)(yrow + dd) = o;
        }
    }
  }
}

constexpr int CP = 136;
constexpr int TP = 40;
DI bf16x8 ld_perm(const u16* rowp, int off) {
  u32x2 lo = *(const u32x2*)(rowp + off);
  u32x2 hi = *(const u32x2*)(rowp + off + 8);
  u32x4 u = {lo.x, lo.y, hi.x, hi.y};
  return __builtin_bit_cast(bf16x8, u);
}
DI bf16x8 pack8(const f32x16& x, int s2) {
  u32x4 u;
  u.x = pack2(x[8 * s2], x[8 * s2 + 1]);
  u.y = pack2(x[8 * s2 + 2], x[8 * s2 + 3]);
  u.z = pack2(x[8 * s2 + 4], x[8 * s2 + 5]);
  u.w = pack2(x[8 * s2 + 6], x[8 * s2 + 7]);
  return __builtin_bit_cast(bf16x8, u);
}

DI float ld_dev(const float* p) { return __hip_atomic_load(p, __ATOMIC_RELAXED, __HIP_MEMORY_SCOPE_AGENT); }
DI void st_dev(float* p, float v) { __hip_atomic_store(p, v, __ATOMIC_RELAXED, __HIP_MEMORY_SCOPE_AGENT); }
DI float4 ld_dev4(const float* p) {
  const unsigned long long* q = (const unsigned long long*)p;
  const unsigned long long a = __hip_atomic_load(q, __ATOMIC_RELAXED, __HIP_MEMORY_SCOPE_AGENT);
  const unsigned long long b = __hip_atomic_load(q + 1, __ATOMIC_RELAXED, __HIP_MEMORY_SCOPE_AGENT);
  return make_float4(__uint_as_float((unsigned)a), __uint_as_float((unsigned)(a >> 32)), __uint_as_float((unsigned)b),
                     __uint_as_float((unsigned)(b >> 32)));
}
DI void st_dev4(float* p, float4 v) {
  unsigned long long* q = (unsigned long long*)p;
  __hip_atomic_store(q, (unsigned long long)__float_as_uint(v.x) | ((unsigned long long)__float_as_uint(v.y) << 32), __ATOMIC_RELAXED,
                     __HIP_MEMORY_SCOPE_AGENT);
  __hip_atomic_store(q + 1, (unsigned long long)__float_as_uint(v.z) | ((unsigned long long)__float_as_uint(v.w) << 32), __ATOMIC_RELAXED,
                     __HIP_MEMORY_SCOPE_AGENT);
}
DI bf16x8 ld_perm_dev(const u16* rowp, int off) {
  const unsigned long long* q = (const unsigned long long*)(rowp + off);
  const unsigned long long a = __hip_atomic_load(q, __ATOMIC_RELAXED, __HIP_MEMORY_SCOPE_AGENT);
  const unsigned long long b = __hip_atomic_load(q + 2, __ATOMIC_RELAXED, __HIP_MEMORY_SCOPE_AGENT);
  u32x4 u = {(unsigned)a, (unsigned)(a >> 32), (unsigned)b, (unsigned)(b >> 32)};
  return __builtin_bit_cast(bf16x8, u);
}
DI void scan_gdn_seg(const Params& p, char* smem, int chain, int seg, int mode) {
  const u16* PROJ = (const u16*)(p.ws + OFF_BIG);
  const float* DAB = (const float*)(p.ws + OFF_DAB);
  const int dir = chain & 1, hd = (chain >> 1) & 3, b = chain >> 3;
  u16* OUT = (u16*)(p.ws + (dir ? OFF_OB : OFF_H));
  u16* Qb = (u16*)smem;
  u16* Kb = Qb + 32 * CP;
  u16* KTT = Kb + 32 * CP;
  u16* VT = KTT + 128 * TP;
  float* VB = (float*)(VT + 128 * TP);
  float* AM = VB + 32 * 128;
  u16* AQK = (u16*)(AM + 32 * 36);
  float* SC = (float*)(AQK + 32 * TP);
  float* cwl = SC + 128;
  int tid0 = threadIdx.x;
  asm volatile("" : "+v"(tid0));
  int tid = tid0, lane = tid & 63, wave = tid >> 6, r = lane & 31, h = lane >> 5;
  int ti = tid >> 3, sj = tid & 7;
  __syncthreads();
  for (int i = tid; i < 1152; i += 256) {
    int tap = i / 384, c = i - tap * 384;
    cwl[i] = p.rec_conv_w[tap * 1536 + (c >> 7) * 512 + hd * 128 + (c & 127)];
  }
  f32x16 S[4];
#pragma unroll
  for (int d = 0; d < 4; ++d) S[d] = zero16();
  float* GS = (float*)(p.ws + OFF_GS);
  u16* GP = (u16*)(p.ws + OFF_GP);
  if (mode == 1) {
#pragma unroll
    for (int d = 0; d < 4; ++d)
#pragma unroll
      for (int i = 0; i < 16; ++i) S[d][i] = (32 * d + crow(i, h) == 32 * wave + r) ? 1.f : 0.f;
  } else if (mode == 2 && seg > 0) {
    const float* src = GS + (size_t)(chain * NHO_G + seg - 1) * 16384 + (32 * wave + r) * 128 + 4 * h;
#pragma unroll
    for (int d = 0; d < 4; ++d)
#pragma unroll
      for (int g4 = 0; g4 < 4; ++g4) {
        const float4 v = ld_dev4(src + 32 * d + 8 * g4);
        S[d][4 * g4] = v.x; S[d][4 * g4 + 1] = v.y; S[d][4 * g4 + 2] = v.z; S[d][4 * g4 + 3] = v.w;
      }
  }
  const float vb_scale = (mode == 1) ? 0.f : 1.f;
  unsigned pf0 = 0u, pf1 = 0u, pfsink = 0u;
  const bool with_out = mode == 2;
  __syncthreads();
  for (int blk = seg * SEGC_G; blk < seg * SEGC_G + SEGC_G; ++blk) {
    tid = tid0;
    asm volatile("" : "+v"(tid));
    lane = tid & 63; wave = __builtin_amdgcn_readfirstlane(tid >> 6); r = lane & 31; h = lane >> 5; ti = tid >> 3; sj = tid & 7;
    const bool isctx = blk < 8;
    const int seg_base = isctx ? 0 : CTX, seg_len = isctx ? CTX : SEQ;
    const int bi = isctx ? blk : blk - 8;
    {
      const int sidx = bi * 32 + ti;
      const int pos = dir ? seg_len - 1 - sidx : sidx;
      const size_t row = (size_t)b * UB + seg_base + pos;
      const u16* pr = PROJ + row * NPROJ;
      const float mp = pos > 0 ? 1.f : 0.f, mn = pos < seg_len - 1 ? 1.f : 0.f;
      const float g = DAB[row * 16 + dir * 4 + hd], beta = DAB[row * 16 + 8 + dir * 4 + hd];
      const float betav = beta * vb_scale;
      if (sj == 0) SC[ti * 4] = g;
#pragma unroll
      for (int pp = 0; pp < 3; ++pp) {
        const int part = (pp + 2) % 3;
        if (part == 0 && !with_out) continue;
        if (part == 2 && mode == 1) {
#pragma unroll
          for (int k = 0; k < 4; ++k) *(float4*)(VB + ti * 128 + sj * 16 + 4 * k) = make_float4(0.f, 0.f, 0.f, 0.f);
          continue;
        }
        float val[16];
        const u16* pc = pr + 2560 + part * 512 + hd * 128 + sj * 16;
        const float* cw = cwl + part * 128 + sj * 16;
#pragma unroll
        for (int half = 0; half < 2; ++half) {
          u32x4 x0 = *(const u32x4*)(pc - NPROJ + half * 8);
          u32x4 x1 = *(const u32x4*)(pc + half * 8);
          u32x4 x2 = *(const u32x4*)(pc + NPROJ + half * 8);
          unsigned a0[4] = {x0.x, x0.y, x0.z, x0.w}, a1[4] = {x1.x, x1.y, x1.z, x1.w}, a2[4] = {x2.x, x2.y, x2.z, x2.w};
#pragma unroll
          for (int k = 0; k < 4; ++k) {
            int c0 = half * 8 + 2 * k;
            float y0 = cw[c0] * mp * bflo(a0[k]) + cw[384 + c0] * bflo(a1[k]) + cw[768 + c0] * mn * bflo(a2[k]);
            float y1 = cw[c0 + 1] * mp * bfhi(a0[k]) + cw[384 + c0 + 1] * bfhi(a1[k]) + cw[768 + c0 + 1] * mn * bfhi(a2[k]);
            val[c0] = siluf_(y0);
            val[c0 + 1] = siluf_(y1);
          }
          __builtin_amdgcn_sched_barrier(0);
        }
        if (part == 2) {
#pragma unroll
          for (int k = 0; k < 4; ++k)
            *(float4*)(VB + ti * 128 + sj * 16 + 4 * k) =
                make_float4(betav * val[4 * k], betav * val[4 * k + 1], betav * val[4 * k + 2], betav * val[4 * k + 3]);
        } else {
          float ss = 0.f;
#pragma unroll
          for (int k = 0; k < 16; ++k) ss += val[k] * val[k];
          ss = dpp_sum8(ss);
          const float rn = rsqrtf(ss + EPS) * (part == 0 ? 0.08838834764831845f : 1.f);
          u16* dstp = (part == 0 ? Qb : Kb) + ti * CP + sj * 16;
#pragma unroll
          for (int hh = 0; hh < 2; ++hh) {
            u32x4 o;
            o.x = pack2(val[8 * hh] * rn, val[8 * hh + 1] * rn); o.y = pack2(val[8 * hh + 2] * rn, val[8 * hh + 3] * rn);
            o.z = pack2(val[8 * hh + 4] * rn, val[8 * hh + 5] * rn); o.w = pack2(val[8 * hh + 6] * rn, val[8 * hh + 7] * rn);
            *(u32x4*)(dstp + 8 * hh) = o;
          }
        }
        __builtin_amdgcn_sched_barrier(0);
      }
      __syncthreads();
      float G = 0.f, Gl = 0.f;
      for (int t = 0; t < 32; ++t) {
        float gt = SC[t * 4];
        Gl += gt;
        G += (t <= ti) ? gt : 0.f;
      }
      const float eG = __expf(G), eT = __expf(Gl - G);
      __syncthreads();
      if (sj == 0) *(float4*)(SC + ti * 4) = make_float4(G, beta, eG, eT);
      if (tid == 0) AM[35] = __expf(Gl);
      {
        const u32x4 k0 = *(const u32x4*)(Kb + ti * CP + sj * 16), k1 = *(const u32x4*)(Kb + ti * CP + sj * 16 + 8);
        const unsigned kk[8] = {k0.x, k0.y, k0.z, k0.w, k1.x, k1.y, k1.z, k1.w};
#pragma unroll
        for (int k = 0; k < 8; ++k) {
          KTT[(sj * 16 + 2 * k) * TP + ti] = f2bf(bflo(kk[k]) * eT);
          KTT[(sj * 16 + 2 * k + 1) * TP + ti] = f2bf(bfhi(kk[k]) * eT);
        }
      }
    }
    __syncthreads();
    f32x16 KS = zero16();
#pragma unroll
    for (int d = 0; d < 4; ++d)
#pragma unroll
      for (int s2 = 0; s2 < 2; ++s2) {
        const bf16x8 sp = pack8(S[d], s2);
        KS = MFMA32(ld_perm(Kb + r * CP, 32 * d + 16 * s2 + 4 * h), sp, KS);
        __builtin_amdgcn_sched_barrier(0);
      }
    if (wave == 0 || (wave == 1 && with_out)) {
      f32x16 X = zero16();
      const u16* ap = (wave == 0 ? Kb : Qb) + r * CP + 8 * h;
      const u16* bp = Kb + r * CP + 8 * h;
#pragma unroll
      for (int ks = 0; ks < 8; ++ks) X = MFMA32(*(const bf16x8*)(ap + 16 * ks), *(const bf16x8*)(bp + 16 * ks), X);
      const float Gs = SC[r * 4];
#pragma unroll
      for (int i = 0; i < 16; ++i) {
        const int c = crow(i, h);
        const float4 sc = *(const float4*)(SC + c * 4);
        const float gam = __expf(fminf(sc.x - Gs, 0.f));
        if (wave == 0) AM[c * 36 + r] = (r < c) ? sc.y * X[i] * gam : 0.f;
        else AQK[c * TP + r] = f2bf((r <= c) ? X[i] * gam : 0.f);
      }
    }
#pragma unroll
    for (int i = 0; i < 16; ++i) {
      const int t = crow(i, h);
      const float4 sc = *(const float4*)(SC + t * 4);
      float* vb = VB + t * 128 + 32 * wave + r;
      *vb = *vb - sc.y * sc.z * KS[i];
    }
    __syncthreads();
    if (tid >= 128) {
      pfsink ^= pf0 ^ pf1;
      pf0 = 0u; pf1 = 0u;
      const int nb = blk + 1;
      if (nb < seg * SEGC_G + SEGC_G) {
        const bool nctx = nb < 8;
        const int nbase = nctx ? 0 : CTX, nlen = nctx ? CTX : SEQ, nbi = nctx ? nb : nb - 8;
        const int rlo = (dir ? nlen - 32 - nbi * 32 : nbi * 32) - 1;
        const u16* pbase = PROJ + ((size_t)b * UB + nbase + rlo) * NPROJ + 2560 + hd * 128;
        const int l0 = tid - 128, l1 = tid;
        pf0 = *(const unsigned*)(pbase + (size_t)(l0 / 6) * NPROJ + ((l0 % 6) >> 1) * 512 + ((l0 % 6) & 1) * 64);
        if (l1 < 204) pf1 = *(const unsigned*)(pbase + (size_t)(l1 / 6) * NPROJ + ((l1 % 6) >> 1) * 512 + ((l1 % 6) & 1) * 64);
        else if (l1 < 220)
          pf1 = __float_as_uint(DAB[((size_t)b * UB + nbase + rlo + 1) * 16 + (l1 - 204) * 32]);
      }
    }
    if (tid < 128) {
      float x[16];
#pragma unroll
      for (int c = 0; c < 16; ++c) {
        float acc = VB[c * 128 + tid];
#pragma unroll
        for (int s4 = 0; s4 < (c + 3) / 4; ++s4) {
          const float4 a4 = *(const float4*)(AM + c * 36 + 4 * s4);
          if (4 * s4 < c) acc -= a4.x * x[4 * s4];
          if (4 * s4 + 1 < c) acc -= a4.y * x[4 * s4 + 1];
          if (4 * s4 + 2 < c) acc -= a4.z * x[4 * s4 + 2];
          if (4 * s4 + 3 < c) acc -= a4.w * x[4 * s4 + 3];
        }
        x[c] = acc;
        __builtin_amdgcn_sched_barrier(0);
      }
#pragma unroll
      for (int q4 = 0; q4 < 2; ++q4) {
        u32x4 u;
        u.x = pack2(x[8 * q4], x[8 * q4 + 1]); u.y = pack2(x[8 * q4 + 2], x[8 * q4 + 3]);
        u.z = pack2(x[8 * q4 + 4], x[8 * q4 + 5]); u.w = pack2(x[8 * q4 + 6], x[8 * q4 + 7]);
        *(u32x4*)(VT + tid * TP + 8 * q4) = u;
      }
#pragma unroll
      for (int c = 16; c < 32; ++c) {
        float acc = VB[c * 128 + tid];
#pragma unroll
        for (int s4 = 0; s4 < 4; ++s4) {
          const float4 a4 = *(const float4*)(AM + c * 36 + 4 * s4);
          acc -= a4.x * x[4 * s4] + a4.y * x[4 * s4 + 1] + a4.z * x[4 * s4 + 2] + a4.w * x[4 * s4 + 3];
        }
        VB[c * 128 + tid] = acc;
        __builtin_amdgcn_sched_barrier(0);
      }
#pragma unroll
      for (int c = 16; c < 32; ++c) {
        float acc = VB[c * 128 + tid];
#pragma unroll
        for (int s4 = 4; s4 < (c + 3) / 4; ++s4) {
          const float4 a4 = *(const float4*)(AM + c * 36 + 4 * s4);
          if (4 * s4 < c) acc -= a4.x * x[4 * s4 - 16];
          if (4 * s4 + 1 < c) acc -= a4.y * x[4 * s4 + 1 - 16];
          if (4 * s4 + 2 < c) acc -= a4.z * x[4 * s4 + 2 - 16];
          if (4 * s4 + 3 < c) acc -= a4.w * x[4 * s4 + 3 - 16];
        }
        x[c - 16] = acc;
        __builtin_amdgcn_sched_barrier(0);
      }
#pragma unroll
      for (int q4 = 0; q4 < 2; ++q4) {
        u32x4 u;
        u.x = pack2(x[8 * q4], x[8 * q4 + 1]); u.y = pack2(x[8 * q4 + 2], x[8 * q4 + 3]);
        u.z = pack2(x[8 * q4 + 4], x[8 * q4 + 5]); u.w = pack2(x[8 * q4 + 6], x[8 * q4 + 7]);
        *(u32x4*)(VT + tid * TP + 16 + 8 * q4) = u;
      }
    }
    __syncthreads();
    {
      const bf16x8 vf0 = *(const bf16x8*)(VT + (32 * wave + r) * TP + 8 * h);
      const bf16x8 vf1 = *(const bf16x8*)(VT + (32 * wave + r) * TP + 16 + 8 * h);
      if (with_out && !isctx) {
        f32x16 QS = zero16();
#pragma unroll
        for (int d = 0; d < 4; ++d)
#pragma unroll
          for (int s2 = 0; s2 < 2; ++s2)
            QS = MFMA32(ld_perm(Qb + r * CP, 32 * d + 16 * s2 + 4 * h), pack8(S[d], s2), QS);
#pragma unroll
        for (int i = 0; i < 16; ++i) QS[i] *= SC[crow(i, h) * 4 + 2];
        QS = MFMA32(*(const bf16x8*)(AQK + r * TP + 8 * h), vf0, QS);
        QS = MFMA32(*(const bf16x8*)(AQK + r * TP + 16 + 8 * h), vf1, QS);
        const int pos0 = dir ? seg_len - 1 - bi * 32 : bi * 32;
        u16* op = OUT + ((size_t)b * UB + seg_base + pos0) * 1024 + 512 + hd * 128 + 32 * wave + r;
        int ostep = dir ? -1024 : 1024;
        asm volatile("" : "+s"(ostep));
#pragma unroll
        for (int i = 0; i < 16; ++i) op[crow(i, h) * ostep] = f2bf(QS[i]);
      }
      const float dec = AM[35];
#pragma unroll
      for (int d = 0; d < 4; ++d) {
#pragma unroll
        for (int i = 0; i < 16; ++i) S[d][i] *= dec;
        S[d] = MFMA32(*(const bf16x8*)(KTT + (32 * d + r) * TP + 8 * h), vf0, S[d]);
        S[d] = MFMA32(*(const bf16x8*)(KTT + (32 * d + r) * TP + 16 + 8 * h), vf1, S[d]);
      }
    }
    __syncthreads();
  }
  if (tid >= 128) ((unsigned*)(p.ws + OFF_BAR))[1 + (tid & 63)] = pfsink ^ pf0 ^ pf1;
  if (mode == 0) {
    float* dst = GS + (size_t)(chain * NHO_G + seg) * 16384 + (32 * wave + r) * 128 + 4 * h;
#pragma unroll
    for (int d = 0; d < 4; ++d)
#pragma unroll
      for (int g4 = 0; g4 < 4; ++g4)
        st_dev4(dst + 32 * d + 8 * g4, make_float4(S[d][4 * g4], S[d][4 * g4 + 1], S[d][4 * g4 + 2], S[d][4 * g4 + 3]));
  } else if (mode == 1) {
    u16* dst = GP + (size_t)(chain * NHO_G + seg) * 16384 + 32 * wave + r;
#pragma unroll
    for (int d = 0; d < 4; ++d)
#pragma unroll
      for (int i = 0; i < 16; ++i) __hip_atomic_store(dst + (32 * d + crow(i, h)) * 128, f2bf(S[d][i]), __ATOMIC_RELAXED, __HIP_MEMORY_SCOPE_AGENT);
  }
}

DI void scan_hgrn_seg(const Params& p, char* smem, int chain, int seg, int mode) {
  const u16* PROJ = (const u16*)(p.ws + OFF_BIG);
  const float* misc = (const float*)(p.ws + OFF_MISC);
  const int dir = chain & 1, hd = (chain >> 1) & 3, b = chain >> 3;
  u16* OUT = (u16*)(p.ws + (dir ? OFF_OB : OFF_H));
  u16* QG = (u16*)smem;
  u16* QP = QG + 32 * CP;
  u16* KT = QP + 32 * CP;
  u16* KTT = KT + 32 * CP;
  u16* VT = KTT + 128 * TP;
  u16* AQK = VT + 128 * TP;
  float* LG = (float*)(AQK + 32 * TP);
  float* GL = LG + 32 * 128;
  float* lbs = GL + 128;
  int tid0 = threadIdx.x;
  asm volatile("" : "+v"(tid0));
  int tid = tid0, lane = tid & 63, wave = tid >> 6, r = lane & 31, h = lane >> 5;
  int ti = tid >> 3, sj = tid & 7;
  __syncthreads();
  if (tid < 128) lbs[tid] = misc[16 + dir * 512 + hd * 128 + tid];
  f32x16 S[4];
#pragma unroll
  for (int d = 0; d < 4; ++d) S[d] = zero16();
  float* HS = (float*)(p.ws + OFF_HS);
  float* HD = (float*)(p.ws + OFF_HD);
  if (mode == 2 && seg > 0) {
    const float* src = HS + (size_t)(chain * NHO_H + seg - 1) * 16384 + (32 * wave + r) * 128 + 4 * h;
#pragma unroll
    for (int d = 0; d < 4; ++d)
#pragma unroll
      for (int g4 = 0; g4 < 4; ++g4) {
        const float4 v = ld_dev4(src + 32 * d + 8 * g4);
        S[d][4 * g4] = v.x; S[d][4 * g4 + 1] = v.y; S[d][4 * g4 + 2] = v.z; S[d][4 * g4 + 3] = v.w;
      }
  }
  const bool with_out = mode == 2;
  float dsum = 0.f;
  __syncthreads();
  for (int blk = seg * SEGC_H; blk < seg * SEGC_H + SEGC_H; ++blk) {
    tid = tid0;
    asm volatile("" : "+v"(tid));
    lane = tid & 63; wave = __builtin_amdgcn_readfirstlane(tid >> 6); r = lane & 31; h = lane >> 5; ti = tid >> 3; sj = tid & 7;
    const bool isctx = blk < 8;
    const int seg_base = isctx ? 0 : CTX, seg_len = isctx ? CTX : SEQ;
    const int bi = isctx ? blk : blk - 8;
    {
      const int sidx = bi * 32 + ti;
      const int pos = dir ? seg_len - 1 - sidx : sidx;
      const size_t row = (size_t)b * UB + seg_base + pos;
      const u16* pr = PROJ + row * NPROJ;
      const u16* pq = pr + hd * 128 + sj * 16;
      const u16* pf = pr + (dir ? 1024 : 512) + hd * 128 + sj * 16;
      const u16* pv = pr + 1536 + hd * 128 + sj * 16;
      u32x4 q0 = *(const u32x4*)pq, q1 = *(const u32x4*)(pq + 8);
      u32x4 f0 = *(const u32x4*)pf, f1 = *(const u32x4*)(pf + 8);
      u32x4 v0 = *(const u32x4*)pv, v1 = *(const u32x4*)(pv + 8);
      unsigned qa[8] = {q0.x, q0.y, q0.z, q0.w, q1.x, q1.y, q1.z, q1.w};
      unsigned fa[8] = {f0.x, f0.y, f0.z, f0.w, f1.x, f1.y, f1.z, f1.w};
      unsigned va[8] = {v0.x, v0.y, v0.z, v0.w, v1.x, v1.y, v1.z, v1.w};
      float qv[16], kv[16];
#pragma unroll
      for (int k = 0; k < 8; ++k) {
        const float l0 = lbs[sj * 16 + 2 * k], l1 = lbs[sj * 16 + 2 * k + 1];
        qv[2 * k] = siluf_(bflo(qa[k])) * 0.08838834764831845f;
        qv[2 * k + 1] = siluf_(bfhi(qa[k])) * 0.08838834764831845f;
        const float fa0 = l0 + (1.f - l0) * sigmoidf_(bflo(fa[k]));
        const float fa1 = l1 + (1.f - l1) * sigmoidf_(bfhi(fa[k]));
        kv[2 * k] = 1.f - fa0;
        kv[2 * k + 1] = 1.f - fa1;
        LG[ti * 128 + sj * 16 + 2 * k] = __logf(fa0);
        LG[ti * 128 + sj * 16 + 2 * k + 1] = __logf(fa1);
        VT[(sj * 16 + 2 * k) * TP + ti] = (u16)(va[k] & 0xffffu);
        VT[(sj * 16 + 2 * k + 1) * TP + ti] = (u16)(va[k] >> 16);
      }
      __syncthreads();
      if (tid < 128) {
        float cv[32];
#pragma unroll
        for (int t = 0; t < 32; ++t) cv[t] = LG[t * 128 + tid];
        float acc = 0.f;
#pragma unroll
        for (int t = 0; t < 32; ++t) {
          acc += cv[t];
          LG[t * 128 + tid] = acc;
        }
        GL[tid] = __expf(acc);
        dsum += acc;
      }
      __syncthreads();
      u32x4 o0[2], o1[2], o2[2];
      unsigned w0[8], w1[8], w2[8];
#pragma unroll
      for (int k = 0; k < 8; ++k) {
        const int d0 = sj * 16 + 2 * k;
        const float G0 = LG[ti * 128 + d0], G1 = LG[ti * 128 + d0 + 1];
        const float L0 = LG[31 * 128 + d0], L1 = LG[31 * 128 + d0 + 1];
        const float kt0 = kv[2 * k] * __expf(L0 - G0), kt1 = kv[2 * k + 1] * __expf(L1 - G1);
        w0[k] = pack2(qv[2 * k] * __expf(G0), qv[2 * k + 1] * __expf(G1));
        w1[k] = pack2(qv[2 * k] * __expf(G0 - L0), qv[2 * k + 1] * __expf(G1 - L1));
        w2[k] = pack2(kt0, kt1);
        KTT[d0 * TP + ti] = (u16)(w2[k] & 0xffffu);
        KTT[(d0 + 1) * TP + ti] = (u16)(w2[k] >> 16);
      }
#pragma unroll
      for (int hh = 0; hh < 2; ++hh) {
        o0[hh] = (u32x4){w0[4 * hh], w0[4 * hh + 1], w0[4 * hh + 2], w0[4 * hh + 3]};
        o1[hh] = (u32x4){w1[4 * hh], w1[4 * hh + 1], w1[4 * hh + 2], w1[4 * hh + 3]};
        o2[hh] = (u32x4){w2[4 * hh], w2[4 * hh + 1], w2[4 * hh + 2], w2[4 * hh + 3]};
        *(u32x4*)(QG + ti * CP + sj * 16 + 8 * hh) = o0[hh];
        *(u32x4*)(QP + ti * CP + sj * 16 + 8 * hh) = o1[hh];
        *(u32x4*)(KT + ti * CP + sj * 16 + 8 * hh) = o2[hh];
      }
    }
    __syncthreads();
    f32x16 QS = zero16();
    if (with_out && !isctx) {
#pragma unroll
      for (int d = 0; d < 4; ++d)
#pragma unroll
        for (int s2 = 0; s2 < 2; ++s2)
          QS = MFMA32(ld_perm(QG + r * CP, 32 * d + 16 * s2 + 4 * h), pack8(S[d], s2), QS);
      if (wave == 0) {
        f32x16 X = zero16();
#pragma unroll
        for (int ks = 0; ks < 8; ++ks)
          X = MFMA32(*(const bf16x8*)(QP + r * CP + 16 * ks + 8 * h), *(const bf16x8*)(KT + r * CP + 16 * ks + 8 * h), X);
#pragma unroll
        for (int i = 0; i < 16; ++i) {
          const int c = crow(i, h);
          AQK[c * TP + r] = f2bf((r <= c) ? X[i] : 0.f);
        }
      }
    }
    __syncthreads();
    {
      const bf16x8 vf0 = *(const bf16x8*)(VT + (32 * wave + r) * TP + 8 * h);
      const bf16x8 vf1 = *(const bf16x8*)(VT + (32 * wave + r) * TP + 16 + 8 * h);
      if (with_out && !isctx) {
        QS = MFMA32(*(const bf16x8*)(AQK + r * TP + 8 * h), vf0, QS);
        QS = MFMA32(*(const bf16x8*)(AQK + r * TP + 16 + 8 * h), vf1, QS);
        const int pos0 = dir ? seg_len - 1 - bi * 32 : bi * 32;
        u16* op = OUT + ((size_t)b * UB + seg_base + pos0) * 1024 + hd * 128 + 32 * wave + r;
        int ostep = dir ? -1024 : 1024;
        asm volatile("" : "+s"(ostep));
#pragma unroll
        for (int i = 0; i < 16; ++i) op[crow(i, h) * ostep] = f2bf(QS[i]);
      }
#pragma unroll
      for (int d = 0; d < 4; ++d) {
#pragma unroll
        for (int i = 0; i < 16; ++i) S[d][i] *= GL[32 * d + crow(i, h)];
        S[d] = MFMA32(*(const bf16x8*)(KTT + (32 * d + r) * TP + 8 * h), vf0, S[d]);
        S[d] = MFMA32(*(const bf16x8*)(KTT + (32 * d + r) * TP + 16 + 8 * h), vf1, S[d]);
      }
    }
    __syncthreads();
  }
  if (mode == 0) {
    float* dst = HS + (size_t)(chain * NHO_H + seg) * 16384 + (32 * wave + r) * 128 + 4 * h;
#pragma unroll
    for (int d = 0; d < 4; ++d)
#pragma unroll
      for (int g4 = 0; g4 < 4; ++g4)
        st_dev4(dst + 32 * d + 8 * g4, make_float4(S[d][4 * g4], S[d][4 * g4 + 1], S[d][4 * g4 + 2], S[d][4 * g4 + 3]));
    if (tid < 128) st_dev(HD + (chain * NHO_H + seg) * 128 + tid, __expf(dsum));
  }
}

DI void combine_gdn(const Params& p, int chain) {
  float* GS = (float*)(p.ws + OFF_GS);
  const u16* GP = (const u16*)(p.ws + OFF_GP);
  const int lane = threadIdx.x & 63, wave = threadIdx.x >> 6, r = lane & 31, h = lane >> 5;
  f32x16 S[4], acc[4];
  {
    const float* src = GS + (size_t)(chain * NHO_G) * 16384 + (32 * wave + r) * 128 + 4 * h;
#pragma unroll
    for (int d = 0; d < 4; ++d)
#pragma unroll
      for (int g4 = 0; g4 < 4; ++g4) {
        const float4 v = ld_dev4(src + 32 * d + 8 * g4);
        S[d][4 * g4] = v.x; S[d][4 * g4 + 1] = v.y; S[d][4 * g4 + 2] = v.z; S[d][4 * g4 + 3] = v.w;
      }
  }
#pragma unroll 1
  for (int j = 1; j < NHO_G; ++j) {
    float* loc = GS + (size_t)(chain * NHO_G + j) * 16384 + (32 * wave + r) * 128 + 4 * h;
    const u16* P = GP + (size_t)(chain * NHO_G + j) * 16384;
#pragma unroll
    for (int d = 0; d < 4; ++d)
#pragma unroll
      for (int g4 = 0; g4 < 4; ++g4) {
        const float4 v = ld_dev4(loc + 32 * d + 8 * g4);
        acc[d][4 * g4] = v.x; acc[d][4 * g4 + 1] = v.y; acc[d][4 * g4 + 2] = v.z; acc[d][4 * g4 + 3] = v.w;
      }
#pragma unroll
    for (int d2 = 0; d2 < 4; ++d2)
#pragma unroll
      for (int s2 = 0; s2 < 2; ++s2) {
        const bf16x8 sp = pack8(S[d2], s2);
#pragma unroll
        for (int d = 0; d < 4; ++d) acc[d] = MFMA32(ld_perm_dev(P + (32 * d + r) * 128, 32 * d2 + 16 * s2 + 4 * h), sp, acc[d]);
        if (s2 == 1) __builtin_amdgcn_sched_barrier(0);
      }
#pragma unroll
    for (int d = 0; d < 4; ++d) {
      S[d] = acc[d];
#pragma unroll
      for (int g4 = 0; g4 < 4; ++g4)
        st_dev4(loc + 32 * d + 8 * g4, make_float4(S[d][4 * g4], S[d][4 * g4 + 1], S[d][4 * g4 + 2], S[d][4 * g4 + 3]));
    }
  }
}
DI void combine_hgrn(const Params& p, int chain) {
  float* HS = (float*)(p.ws + OFF_HS);
  const float* HD = (const float*)(p.ws + OFF_HD);
  const int lane = threadIdx.x & 63, wave = threadIdx.x >> 6, r = lane & 31, h = lane >> 5;
  float4 S[16];
  {
    const float* src = HS + (size_t)(chain * NHO_H) * 16384 + (32 * wave + r) * 128 + 4 * h;
#pragma unroll
    for (int q = 0; q < 16; ++q) S[q] = ld_dev4(src + 8 * q);
  }
#pragma unroll 1
  for (int j = 1; j < NHO_H; ++j) {
    float* loc = HS + (size_t)(chain * NHO_H + j) * 16384 + (32 * wave + r) * 128 + 4 * h;
    const float* D = HD + (chain * NHO_H + j) * 128 + 4 * h;
#pragma unroll
    for (int q = 0; q < 16; ++q) {
      const float4 l = ld_dev4(loc + 8 * q), dd = ld_dev4(D + 8 * q);
      S[q] = make_float4(dd.x * S[q].x + l.x, dd.y * S[q].y + l.y, dd.z * S[q].z + l.z, dd.w * S[q].w + l.w);
      st_dev4(loc + 8 * q, S[q]);
      if ((q & 3) == 3) __builtin_amdgcn_sched_barrier(0);
    }
  }
}

DI void phase_scan(const Params& p, char* smem, const XcdBarrier& xb) {
  for (int item = blockIdx.x; item < 32 * NHO_G * 2 + 32 * NHO_H; item += gridDim.x) {
    if (item < 32 * NHO_G * 2) {
      const int rest = item >> 5;
      scan_gdn_seg(p, smem, item & 31, rest >> 1, rest & 1);
    } else {
      const int k = item - 32 * NHO_G * 2;
      scan_hgrn_seg(p, smem, k & 31, k >> 5, 0);
    }
  }
  xcd_barrier(xb);
  for (int item = blockIdx.x; item < 64; item += gridDim.x) {
    if (item < 32) combine_gdn(p, item);
    else combine_hgrn(p, item - 32);
  }
  xcd_barrier(xb);
  for (int item = blockIdx.x; item < 32 * NSEG_H + 32 * NSEG_G; item += gridDim.x) {
    if (item < 32 * NSEG_H) scan_hgrn_seg(p, smem, item & 31, item >> 5, 2);
    else scan_gdn_seg(p, smem, item & 31, (item - 32 * NSEG_H) >> 5, 2);
  }
}

DI void phase_merge(const Params& p) {
  const u16* PROJ = (const u16*)(p.ws + OFF_BIG);
  u16* H = (u16*)(p.ws + OFF_H);
  const u16* OB = (const u16*)(p.ws + OFF_OB);
  const int lane = threadIdx.x & 63, wave = threadIdx.x >> 6;
  for (int item = blockIdx.x; item < NB * SEQ / 4; item += gridDim.x) {
    int tkn = item * 4 + wave;
    int b = tkn / SEQ, t = tkn - b * SEQ;
    size_t row = (size_t)b * UB + CTX + t;
    int c0 = lane * 16;
    int kind = c0 >> 9;
    const u16* gp = PROJ + row * NPROJ + (kind ? 4096 + (c0 - 512) : 2048 + c0);
    const float* w = (kind ? p.rec_d_norm : p.rec_c_norm) + (c0 & 127);
    u16* hp = H + row * 1024 + c0;
    const u16* bp = OB + row * 1024 + c0;
    float o[16], gt[16];
    float ss = 0.f;
#pragma unroll
    for (int half = 0; half < 2; ++half) {
      uint4 a = *(const uint4*)(hp + half * 8), bq = *(const uint4*)(bp + half * 8), g = *(const uint4*)(gp + half * 8);
      unsigned aa[4] = {a.x, a.y, a.z, a.w}, bb[4] = {bq.x, bq.y, bq.z, bq.w}, gg[4] = {g.x, g.y, g.z, g.w};
#pragma unroll
      for (int k = 0; k < 4; ++k) {
        int c = half * 8 + 2 * k;
        o[c] = bflo(aa[k]) + bflo(bb[k]);
        o[c + 1] = bfhi(aa[k]) + bfhi(bb[k]);
        gt[c] = bflo(gg[k]);
        gt[c + 1] = bfhi(gg[k]);
        ss += o[c] * o[c] + o[c + 1] * o[c + 1];
      }
    }
    ss = dpp_sum8(ss);
    float rs = rsqrtf(ss * (1.f / 128.f) + EPS);
    uint4 r0, r1;
    unsigned rr[8];
#pragma unroll
    for (int k = 0; k < 8; ++k)
      rr[k] = pack2(o[2 * k] * rs * w[2 * k] * siluf_(gt[2 * k]), o[2 * k + 1] * rs * w[2 * k + 1] * siluf_(gt[2 * k + 1]));
    r0.x = rr[0]; r0.y = rr[1]; r0.z = rr[2]; r0.w = rr[3];
    r1.x = rr[4]; r1.y = rr[5]; r1.z = rr[6]; r1.w = rr[7];
    *(uint4*)hp = r0;
    *(uint4*)(hp + 8) = r1;
  }
}

constexpr int N_PHASES = 17;
#ifndef PH_MASK
#define PH_MASK 0xFFFFFFFFu
#endif
#ifndef DUP_PH
#define DUP_PH -1
#endif
__global__ void __launch_bounds__(256, 2) hybrid_trunk_kernel(Params p) {
  __shared__ __attribute__((aligned(16))) char smem[79872];
  cg::grid_group grid = cg::this_grid();
  __shared__ uint4 xb_words;
  if (threadIdx.x == 0) xb_words = make_uint4(0u, 0u, 0u, 0u);
  __syncthreads();
  XcdBarrier xb = xcd_barrier_post((unsigned*)(p.ws + OFF_BAR), (volatile LAS unsigned*)&xb_words);
  if (p.ph_hi > 1000) grid.sync();
  if constexpr ((PH_MASK >> 0) & 1u) {
    if (p.ph_lo <= 0 && 0 < p.ph_hi) {
      if (0 > p.ph_lo) xcd_barrier(xb);
      phase_prep(p, smem);
      if constexpr (DUP_PH == 0) { grid.sync(); phase_prep(p, smem); }
    }
  }
  if constexpr ((PH_MASK >> 1) & 1u) {
    if (p.ph_lo <= 1 && 1 < p.ph_hi) {
      if (1 > p.ph_lo) xcd_barrier(xb);
      phase_norm(p, 0, 0, false);
      if constexpr (DUP_PH == 1) { grid.sync(); phase_norm(p, 0, 0, false); }
    }
  }
  if constexpr ((PH_MASK >> 2) & 1u) {
    if (p.ph_lo <= 2 && 2 < p.ph_hi) {
      if (2 > p.ph_lo) xcd_barrier(xb);
      phase_gemm_att_in(p, smem);
      if constexpr (DUP_PH == 2) { grid.sync(); phase_gemm_att_in(p, smem); }
    }
  }
  if constexpr ((PH_MASK >> 3) & 1u) {
    if (p.ph_lo <= 3 && 3 < p.ph_hi) {
      if (3 > p.ph_lo) xcd_barrier(xb);
      phase_attn(p, smem);
      if constexpr (DUP_PH == 3) { grid.sync(); phase_attn(p, smem); }
    }
  }
  if constexpr ((PH_MASK >> 4) & 1u) {
    if (p.ph_lo <= 4 && 4 < p.ph_hi) {
      if (4 > p.ph_lo) xcd_barrier(xb);
      phase_gemm_resid(p, smem, (const u16*)(p.ws + OFF_H), 1024, (const u16*)(p.ws + OFF_W_MIX), 1024, 0, 2, true, false);
      if constexpr (DUP_PH == 4) { grid.sync(); phase_gemm_resid(p, smem, (const u16*)(p.ws + OFF_H), 1024, (const u16*)(p.ws + OFF_W_MIX), 1024, 0, 2, true, false); }
    }
  }
  if constexpr ((PH_MASK >> 5) & 1u) {
    if (p.ph_lo <= 5 && 5 < p.ph_hi) {
      if (5 > p.ph_lo) xcd_barrier(xb);
      phase_norm(p, 0, 1, false);
      if constexpr (DUP_PH == 5) { grid.sync(); phase_norm(p, 0, 1, false); }
    }
  }
  if constexpr ((PH_MASK >> 6) & 1u) {
    if (p.ph_lo <= 6 && 6 < p.ph_hi) {
      if (6 > p.ph_lo) xcd_barrier(xb);
      phase_gemm_gu(p, smem, 0, false);
      if constexpr (DUP_PH == 6) { grid.sync(); phase_gemm_gu(p, smem, 0, false); }
    }
  }
  if constexpr ((PH_MASK >> 7) & 1u) {
    if (p.ph_lo <= 7 && 7 < p.ph_hi) {
      if (7 > p.ph_lo) xcd_barrier(xb);
      phase_gemm_resid(p, smem, (const u16*)(p.ws + OFF_BIG), DFF, (const u16*)(p.ws + OFF_W_DN), DFF, 0, 5, false, false);
      if constexpr (DUP_PH == 7) { grid.sync(); phase_gemm_resid(p, smem, (const u16*)(p.ws + OFF_BIG), DFF, (const u16*)(p.ws + OFF_W_DN), DFF, 0, 5, false, false); }
    }
  }
  if constexpr ((PH_MASK >> 8) & 1u) {
    if (p.ph_lo <= 8 && 8 < p.ph_hi) {
      if (8 > p.ph_lo) xcd_barrier(xb);
      phase_norm(p, 1, 2, false);
      if constexpr (DUP_PH == 8) { grid.sync(); phase_norm(p, 1, 2, false); }
    }
  }
  if constexpr ((PH_MASK >> 9) & 1u) {
    if (p.ph_lo <= 9 && 9 < p.ph_hi) {
      if (9 > p.ph_lo) xcd_barrier(xb);
      phase_gemm_rec_in(p, smem);
      if constexpr (DUP_PH == 9) { grid.sync(); phase_gemm_rec_in(p, smem); }
    }
  }
  if constexpr ((PH_MASK >> 10) & 1u) {
    if (p.ph_lo <= 10 && 10 < p.ph_hi) {
      if (10 > p.ph_lo) xcd_barrier(xb);
      phase_scan(p, smem, xb);
      if constexpr (DUP_PH == 10) { xcd_barrier(xb); phase_scan(p, smem, xb); }
    }
  }
  if constexpr ((PH_MASK >> 11) & 1u) {
    if (p.ph_lo <= 11 && 11 < p.ph_hi) {
      if (11 > p.ph_lo) xcd_barrier(xb);
      phase_merge(p);
      if constexpr (DUP_PH == 11) { grid.sync(); phase_merge(p); }
    }
  }
  if constexpr ((PH_MASK >> 12) & 1u) {
    if (p.ph_lo <= 12 && 12 < p.ph_hi) {
      if (12 > p.ph_lo) xcd_barrier(xb);
      phase_gemm_resid(p, smem, (const u16*)(p.ws + OFF_H), 1024, (const u16*)(p.ws + OFF_W_MIX) + (size_t)1024 * 1024, 1024, 1, 2, false, true);
      if constexpr (DUP_PH == 12) { grid.sync(); phase_gemm_resid(p, smem, (const u16*)(p.ws + OFF_H), 1024, (const u16*)(p.ws + OFF_W_MIX) + (size_t)1024 * 1024, 1024, 1, 2, false, true); }
    }
  }
  if constexpr ((PH_MASK >> 13) & 1u) {
    if (p.ph_lo <= 13 && 13 < p.ph_hi) {
      if (13 > p.ph_lo) xcd_barrier(xb);
      phase_norm(p, 1, 1, true);
      if constexpr (DUP_PH == 13) { grid.sync(); phase_norm(p, 1, 1, true); }
    }
  }
  if constexpr ((PH_MASK >> 14) & 1u) {
    if (p.ph_lo <= 14 && 14 < p.ph_hi) {
      if (14 > p.ph_lo) xcd_barrier(xb);
      phase_gemm_gu(p, smem, 1, true);
      if constexpr (DUP_PH == 14) { grid.sync(); phase_gemm_gu(p, smem, 1, true); }
    }
  }
  if constexpr ((PH_MASK >> 15) & 1u) {
    if (p.ph_lo <= 15 && 15 < p.ph_hi) {
      if (15 > p.ph_lo) xcd_barrier(xb);
      phase_gemm_resid(p, smem, (const u16*)(p.ws + OFF_BIG), DFF, (const u16*)(p.ws + OFF_W_DN) + (size_t)1024 * DFF, DFF, 1, 5, false, true);
      if constexpr (DUP_PH == 15) { grid.sync(); phase_gemm_resid(p, smem, (const u16*)(p.ws + OFF_BIG), DFF, (const u16*)(p.ws + OFF_W_DN) + (size_t)1024 * DFF, DFF, 1, 5, false, true); }
    }
  }
  if constexpr ((PH_MASK >> 16) & 1u) {
    if (p.ph_lo <= 16 && 16 < p.ph_hi) {
      if (16 > p.ph_lo) xcd_barrier(xb);
      phase_final(p);
      if constexpr (DUP_PH == 16) { grid.sync(); phase_final(p); }
    }
  }
}

extern "C" void kernel_launch(void* const* d_in, const int* in_sizes, int n_in, void* d_out, int out_size, void* d_ws,
                              size_t ws_size, hipStream_t stream) {
  static int grid_blocks = 0;
  if (!grid_blocks) {
    int dev = 0, cus = 0, per_cu = 0;
    hipGetDevice(&dev);
    hipDeviceGetAttribute(&cus, hipDeviceAttributeMultiprocessorCount, dev);
    hipOccupancyMaxActiveBlocksPerMultiprocessor(&per_cu, hybrid_trunk_kernel, 256, 0);
    if (per_cu > 2) per_cu = 2;
    if (per_cu < 1) per_cu = 1;
    grid_blocks = cus * per_cu;
  }
  if (ws_size < WS_NEED) fprintf(stderr, "workspace too small: %zu < %zu\n", ws_size, (size_t)WS_NEED);
  Params p{};
  const float** pf = (const float**)&p;
  for (int i = 0; i < 24; ++i) pf[i] = (const float*)d_in[i];
  p.out = (float*)d_out;
  p.ws = (char*)d_ws;
#if ONE_LAUNCH
  p.ph_lo = 0;
  p.ph_hi = N_PHASES;
  (void)hipMemsetAsync((char*)d_ws + OFF_BAR, 0, XCD_BAR_WORDS * sizeof(unsigned), stream);
  void* args[] = {&p};
  hipError_t e = hipLaunchCooperativeKernel((const void*)hybrid_trunk_kernel, dim3(grid_blocks), dim3(256), args, 0, stream);
  if (e != hipSuccess) fprintf(stderr, "cooperative launch failed: %s (grid %d)\n", hipGetErrorString(e), grid_blocks);
#else
  for (int ph = 0; ph < N_PHASES; ++ph) {
    p.ph_lo = ph;
    p.ph_hi = ph + 1;
    hipLaunchKernelGGL(hybrid_trunk_kernel, dim3(grid_blocks), dim3(256), 0, stream, p);
  }
#endif
}
```
